# Optimizing an MI355X kernel written in HIP

```python
import jax, jax.numpy as jnp
from jax import lax
import numpy as np

D_MODEL = 1024
BATCH = 8
SEQ = 2048
DEPTH = 4
DEC_BATCH = 32
DEC_SEQ = 8
PAST_LEN = 8192
PAGE_SIZE = 128

N_EVEN = (DEPTH + 1) // 2
N_ODD = DEPTH // 2
D_FF = 4 * D_MODEL
A_WIDTH = D_MODEL // 2
A_GROUPS = 4
A_CG = A_WIDTH // A_GROUPS
CHUNK = 128
B_WIDTH = D_MODEL // 2
B_HEAD_DIM = 64
B_HEADS = B_WIDTH // B_HEAD_DIM
B_LORA_W = 32
B_LORA_A = 32
B_LORA_G = 64
B_COLS = 3 * B_WIDTH + B_LORA_W + B_LORA_A + B_LORA_G
EVEN_IN = 2 * A_WIDTH + B_COLS
C_HEAD_DIM = 64
C_HEADS = D_MODEL // C_HEAD_DIM
ROT_DIM = C_HEAD_DIM // 4
ROPE_THETA = 500000.0
DILATED = ((128, 1), (512, 4), (2048, 16))
WIN_MAX = 2048
BAND = 128
NORM_EPS = 1e-6
LN_EPS = 1e-5
GN_EPS = 64e-5
NEG = -1e30

kernel_name = 'hybrid_gmlp_rwkv7_dilated_attn_decoder_step'


def rmsnorm(x, g):
    xf = x.astype(jnp.float32)
    return xf * lax.rsqrt(jnp.mean(xf * xf, axis=-1, keepdims=True) + NORM_EPS) * g


def ada_params(c, w, b):
    m = jax.nn.silu(c.astype(jnp.float32)) @ w + b
    return jnp.split(m[:, None, :], 6, axis=-1)


def modulate(x, g, shift, scale):
    return rmsnorm(x, g) * (1.0 + scale) + shift


def sq_relu_ffn(h, w1, w2):
    return jnp.square(jax.nn.relu(h @ w1)) @ w2


def gmlp_spatial_gate(pa, ln_g, ln_b, ws, bs):
    n, t_len, _ = pa.shape
    u = jax.nn.gelu(pa[..., :A_WIDTH], approximate=False)
    v = jax.nn.gelu(pa[..., A_WIDTH:], approximate=False).astype(jnp.float32)
    mu = jnp.mean(v, axis=-1, keepdims=True)
    var = jnp.mean(jnp.square(v - mu), axis=-1, keepdims=True)
    v = (v - mu) * lax.rsqrt(var + LN_EPS) * ln_g + ln_b
    n_chunks = -(-t_len // CHUNK)
    t_pad = n_chunks * CHUNK
    vc = jnp.pad(v, ((0, 0), (0, t_pad - t_len), (0, 0))).reshape(n, n_chunks, CHUNK, A_GROUPS, A_CG)
    w_causal = ws * jnp.tril(jnp.ones((CHUNK, CHUNK), jnp.float32))
    z = jnp.einsum('gij,bnjgc->bnigc', w_causal, vc) + bs.T[None, None, :, :, None]
    z = z.reshape(n, t_pad, A_WIDTH)[:, :t_len]
    return u * z, v


def wkv7_scan(s0, r, w, k, v, a, b):
    def step(s, xs):
        r_t, w_t, k_t, v_t, a_t, b_t = xs
        sa = jnp.einsum('bhvk,bhk->bhv', s, a_t)
        s = s * w_t[:, :, None, :] + sa[..., :, None] * b_t[..., None, :] + v_t[..., :, None] * k_t[..., None, :]
        return s, jnp.einsum('bhvk,bhk->bhv', s, r_t)
    xs = tuple(jnp.swapaxes(t, 0, 1) for t in (r, w, k, v, a, b))
    s, o = lax.scan(step, s0, xs)
    return s, jnp.swapaxes(o, 0, 1)


def rwkv7_time_mix(pb, prev, s0, mu, w0, w2, a0, a2, g2, k_k, k_a, r_k, lnx_g, lnx_b):
    f32 = jnp.float32
    n, t_len, _ = pb.shape
    pb = pb.astype(f32)
    shifted = jnp.concatenate([prev[:, None, :].astype(f32), pb[:, :-1]], axis=1)
    xm = pb + mu * (shifted - pb)
    cuts = [B_WIDTH, 2 * B_WIDTH, 3 * B_WIDTH, 3 * B_WIDTH + B_LORA_W, 3 * B_WIDTH + B_LORA_W + B_LORA_A]
    r, k, v, xw, xa, xg = jnp.split(xm, cuts, axis=-1)
    w_log = -jax.nn.softplus(-(w0 + jnp.tanh(xw) @ w2)) - 0.5
    decay = jnp.exp(-jnp.exp(w_log))
    a = jax.nn.sigmoid(a0 + xa @ a2)
    g = jax.nn.sigmoid(xg) @ g2
    heads = lambda t: t.reshape(n, t_len, B_HEADS, B_HEAD_DIM)
    kk = heads(k * k_k)
    kk = kk * lax.rsqrt(jnp.sum(kk * kk, axis=-1, keepdims=True) + 1e-12)
    k = k * (1.0 + (a - 1.0) * k_a)
    rh, kh, vh, ah = heads(r), heads(k), heads(v), heads(a)
    s, o = wkv7_scan(s0.astype(f32), rh, heads(decay), kh, vh, -kk, kk * ah)
    mo = jnp.mean(o, axis=-1, keepdims=True)
    vo = jnp.mean(jnp.square(o - mo), axis=-1, keepdims=True)
    o = ((o - mo) * lax.rsqrt(vo + GN_EPS)).reshape(n, t_len, B_WIDTH) * lnx_g + lnx_b
    bonus = jnp.sum(rh * kh * r_k, axis=-1, keepdims=True) * vh
    return (o + bonus.reshape(n, t_len, B_WIDTH)) * g, s


def even_mixer(h, s0, prev, w_in, w_out, ln_g, ln_b, ws, bs, mu, w0, w2, a0, a2, g2, k_k, k_a, r_k, lnx_g, lnx_b):
    proj = h @ w_in
    out_a, v_rows = gmlp_spatial_gate(proj[..., :2 * A_WIDTH], ln_g, ln_b, ws, bs)
    pb = proj[..., 2 * A_WIDTH:]
    out_b, s = rwkv7_time_mix(pb, prev, s0, mu, w0, w2, a0, a2, g2, k_k, k_a, r_k, lnx_g, lnx_b)
    y = jnp.concatenate([out_a, out_b], axis=-1) @ w_out
    return y, s, pb[:, -1].astype(jnp.float32), v_rows


def rope_partial(t, pos):
    half = ROT_DIM // 2
    inv = ROPE_THETA ** (-jnp.arange(half, dtype=jnp.float32) * (2.0 / ROT_DIM))
    ang = pos.astype(jnp.float32)[:, None] * inv[None, :]
    cos = jnp.cos(ang)[None, :, None, :]
    sin = jnp.sin(ang)[None, :, None, :]
    t1, t2, rest = t[..., :half], t[..., half:ROT_DIM], t[..., ROT_DIM:]
    return jnp.concatenate([t1 * cos - t2 * sin, t2 * cos + t1 * sin, rest], axis=-1)


def qkv_heads(h, w_qkv, pos):
    n, t_len, _ = h.shape
    q, k, v = jnp.split((h @ w_qkv).astype(jnp.float32), 3, axis=-1)
    q, k, v = (t.reshape(n, t_len, C_HEADS, C_HEAD_DIM) for t in (q, k, v))
    return rope_partial(q, pos), rope_partial(k, pos), v


def dilated_band_attn(q, k, v, window, dil):
    n, s_len, n_h, e = q.shape
    sub_len = s_len // dil
    sub_w = window // dil
    nb = -(-sub_len // BAND)
    l_pad = nb * BAND
    scale = C_HEAD_DIM ** -0.5

    def to_sub(t):
        t = t.reshape(n, sub_len, dil, n_h, e).transpose(0, 2, 1, 3, 4)
        t = jnp.pad(t, ((0, 0), (0, 0), (0, l_pad - sub_len), (0, 0), (0, 0)))
        return t.reshape(n, dil, nb, BAND, n_h, e)

    def band(t):
        prev = jnp.pad(t, ((0, 0), (0, 0), (1, 0), (0, 0), (0, 0), (0, 0)))[:, :, :-1]
        return jnp.concatenate([prev, t], axis=3)

    qb, kb, vb = to_sub(q), to_sub(k), to_sub(v)
    kband, vband = band(kb), band(vb)
    s = jnp.einsum('brnqhe,brnkhe->brnhqk', qb, kband) * scale
    dist = (jnp.arange(BAND)[:, None] + BAND) - jnp.arange(2 * BAND)[None, :]
    key_m = jnp.arange(nb)[:, None] * BAND - BAND + jnp.arange(2 * BAND)[None, :]
    mask = ((dist >= 0) & (dist <= sub_w))[None, :, :] & (key_m >= 0)[:, None, :]
    s = jnp.where(mask[None, None, :, None], s, NEG)
    m = jnp.max(s, axis=-1, keepdims=True)
    p = jnp.exp(s - m)
    den = jnp.sum(p, axis=-1, keepdims=True)
    o = jnp.einsum('brnhqk,brnkhe->brnqhe', p, vband) / jnp.swapaxes(den, 3, 4)
    lse = jnp.swapaxes((m + jnp.log(den))[..., 0], 3, 4)

    def from_sub(t):
        t = t.reshape((n, dil, l_pad) + t.shape[4:])[:, :, :sub_len]
        t = jnp.swapaxes(t, 1, 2)
        return t.reshape((n, s_len) + t.shape[3:])

    return from_sub(o), from_sub(lse)


def dilated_gather_attn(q, k_all, v_all, window, dil):
    n, t_len, n_h, e = q.shape
    wb = k_all.shape[1] - t_len
    j = jnp.arange(window // dil + 1)
    t = jnp.arange(t_len)
    idx = wb + t[:, None] - j[None, :] * dil
    valid = (idx >= 0) & (PAST_LEN + t[:, None] - j[None, :] * dil >= 0)
    idx = jnp.maximum(idx, 0)
    kg = k_all[:, idx]
    vg = v_all[:, idx]
    s = jnp.einsum('bthe,btjhe->bthj', q, kg) * (C_HEAD_DIM ** -0.5)
    s = jnp.where(valid[None, :, None, :], s, NEG)
    m = jnp.max(s, axis=-1, keepdims=True)
    p = jnp.exp(s - m)
    den = jnp.sum(p, axis=-1, keepdims=True)
    o = jnp.einsum('bthj,btjhe->bthe', p, vg) / den
    return o, (m + jnp.log(den))[..., 0]


def mix_dilations(outs, lses):
    wts = jax.nn.softmax(jnp.stack(lses, axis=0), axis=0)
    return jnp.sum(jnp.stack(outs, axis=0) * wts[..., None], axis=0)


def attn_prompt(h, w_qkv, w_out):
    n, s_len, _ = h.shape
    q, k, v = qkv_heads(h, w_qkv, jnp.arange(s_len))
    res = [dilated_band_attn(q, k, v, w, d) for (w, d) in DILATED]
    o = mix_dilations([r[0] for r in res], [r[1] for r in res])
    keep = min(WIN_MAX, s_len)
    return o.reshape(n, s_len, D_MODEL) @ w_out, k[:, s_len - keep:], v[:, s_len - keep:]


def attn_sample(h, ck, cv, w_qkv, w_out):
    n, t_len, _ = h.shape
    q, k, v = qkv_heads(h, w_qkv, PAST_LEN + jnp.arange(t_len))
    k_all = jnp.concatenate([ck.astype(jnp.float32), k], axis=1)
    v_all = jnp.concatenate([cv.astype(jnp.float32), v], axis=1)
    res = [dilated_gather_attn(q, k_all, v_all, w, d) for (w, d) in DILATED]
    o = mix_dilations([r[0] for r in res], [r[1] for r in res])
    return o.reshape(n, t_len, D_MODEL) @ w_out, k, v


def setup_inputs(seed: int = 0) -> dict:
    key = jax.random.key(seed)
    keys = iter(jax.random.split(key, 48))
    f32 = jnp.float32
    D = D_MODEL
    wbuf = min(WIN_MAX, PAST_LEN)
    nrm = lambda shape, std: jax.random.normal(next(keys), shape, f32) * std
    uni = lambda shape, lo, hi: jax.random.uniform(next(keys), shape, f32, lo, hi)
    return {
        'x_prompt': nrm((BATCH, SEQ, D), 1.0),
        'x_sample': nrm((DEC_BATCH, DEC_SEQ, D), 1.0),
        'state_wkv': nrm((N_EVEN, DEC_BATCH, B_HEADS, B_HEAD_DIM, B_HEAD_DIM), 0.1),
        'state_shift': nrm((N_EVEN, DEC_BATCH, B_COLS), 1.0),
        'cache_k': nrm((N_ODD, DEC_BATCH, wbuf, C_HEADS, C_HEAD_DIM), 1.0),
        'cache_v': nrm((N_ODD, DEC_BATCH, wbuf, C_HEADS, C_HEAD_DIM), 1.0),
        'c_prompt': nrm((BATCH, D), 1.0),
        'c_sample': nrm((DEC_BATCH, D), 1.0),
        'ada_w': nrm((DEPTH, D, 6 * D), 0.5 * D ** -0.5),
        'ada_b': nrm((DEPTH, 6 * D), 0.02),
        'norm_mix_pre': 1.0 + nrm((DEPTH, D), 0.05),
        'norm_mix_post': 1.0 + nrm((DEPTH, D), 0.05),
        'norm_ffn_pre': 1.0 + nrm((DEPTH, D), 0.05),
        'norm_ffn_post': 1.0 + nrm((DEPTH, D), 0.05),
        'ffn_w1': nrm((DEPTH, D, D_FF), D ** -0.5),
        'ffn_w2': nrm((DEPTH, D_FF, D), D_FF ** -0.5),
        'ev_w_in': nrm((N_EVEN, D, EVEN_IN), D ** -0.5),
        'ev_w_out': nrm((N_EVEN, A_WIDTH + B_WIDTH, D), (A_WIDTH + B_WIDTH) ** -0.5),
        'gm_ln_g': 1.0 + nrm((N_EVEN, A_WIDTH), 0.05),
        'gm_ln_b': nrm((N_EVEN, A_WIDTH), 0.02),
        'gm_ws': nrm((N_EVEN, A_GROUPS, CHUNK, CHUNK), CHUNK ** -0.5),
        'gm_bs': 1.0 + nrm((N_EVEN, A_GROUPS, CHUNK), 0.05),
        'rw_mu': uni((N_EVEN, B_COLS), 0.0, 1.0),
        'rw_w0': uni((N_EVEN, B_WIDTH), -3.0, 1.0),
        'rw_w2': nrm((N_EVEN, B_LORA_W, B_WIDTH), B_LORA_W ** -0.5),
        'rw_a0': nrm((N_EVEN, B_WIDTH), 0.5),
        'rw_a2': nrm((N_EVEN, B_LORA_A, B_WIDTH), B_LORA_A ** -0.5),
        'rw_g2': nrm((N_EVEN, B_LORA_G, B_WIDTH), B_LORA_G ** -0.5),
        'rw_kk': 0.85 + nrm((N_EVEN, B_WIDTH), 0.05),
        'rw_ka': 1.0 + nrm((N_EVEN, B_WIDTH), 0.05),
        'rw_rk': nrm((N_EVEN, B_HEADS, B_HEAD_DIM), 0.1),
        'rw_lnx_g': 1.0 + nrm((N_EVEN, B_WIDTH), 0.05),
        'rw_lnx_b': nrm((N_EVEN, B_WIDTH), 0.02),
        'od_w_qkv': nrm((N_ODD, D, 3 * D), D ** -0.5),
        'od_w_out': nrm((N_ODD, D, D), D ** -0.5),
    }


def reference(x_prompt, x_sample, state_wkv, state_shift, cache_k, cache_v, c_prompt, c_sample,
              ada_w, ada_b, norm_mix_pre, norm_mix_post, norm_ffn_pre, norm_ffn_post, ffn_w1, ffn_w2,
              ev_w_in, ev_w_out, gm_ln_g, gm_ln_b, gm_ws, gm_bs, rw_mu, rw_w0, rw_w2, rw_a0, rw_a2,
              rw_g2, rw_kk, rw_ka, rw_rk, rw_lnx_g, rw_lnx_b, od_w_qkv, od_w_out):
    f32 = jnp.float32
    xp = x_prompt.astype(f32)
    xs = x_sample.astype(f32)
    n_p = x_prompt.shape[0]
    wkv_p, shift_p, k_p, v_p = [], [], [], []
    wkv_s, shift_s, k_s, v_s, gv_s = [], [], [], [], []
    for l in range(DEPTH):
        shm_p, scm_p, gtm_p, shf_p, scf_p, gtf_p = ada_params(c_prompt, ada_w[l], ada_b[l])
        shm_s, scm_s, gtm_s, shf_s, scf_s, gtf_s = ada_params(c_sample, ada_w[l], ada_b[l])
        hp = modulate(xp, norm_mix_pre[l], shm_p, scm_p)
        hs = modulate(xs, norm_mix_pre[l], shm_s, scm_s)
        if l % 2 == 0:
            e = l // 2
            ew = (ev_w_in[e], ev_w_out[e], gm_ln_g[e], gm_ln_b[e], gm_ws[e], gm_bs[e], rw_mu[e],
                  rw_w0[e], rw_w2[e], rw_a0[e], rw_a2[e], rw_g2[e], rw_kk[e], rw_ka[e], rw_rk[e],
                  rw_lnx_g[e], rw_lnx_b[e])
            s0 = jnp.zeros((n_p, B_HEADS, B_HEAD_DIM, B_HEAD_DIM), f32)
            prev0 = jnp.zeros((n_p, B_COLS), f32)
            yp, sp, lastp, _ = even_mixer(hp, s0, prev0, *ew)
            ys, ss, lasts, gvs = even_mixer(hs, state_wkv[e], state_shift[e], *ew)
            wkv_p.append(sp)
            shift_p.append(lastp)
            wkv_s.append(ss)
            shift_s.append(lasts)
            gv_s.append(gvs)
        else:
            o = l // 2
            yp, kp, vp = attn_prompt(hp, od_w_qkv[o], od_w_out[o])
            ys, kss, vss = attn_sample(hs, cache_k[o], cache_v[o], od_w_qkv[o], od_w_out[o])
            k_p.append(kp)
            v_p.append(vp)
            k_s.append(kss)
            v_s.append(vss)
        xp = xp + gtm_p * rmsnorm(yp, norm_mix_post[l])
        xs = xs + gtm_s * rmsnorm(ys, norm_mix_post[l])
        fp = modulate(xp, norm_ffn_pre[l], shf_p, scf_p)
        fs = modulate(xs, norm_ffn_pre[l], shf_s, scf_s)
        xp = xp + gtf_p * rmsnorm(sq_relu_ffn(fp, ffn_w1[l], ffn_w2[l]), norm_ffn_post[l])
        xs = xs + gtf_s * rmsnorm(sq_relu_ffn(fs, ffn_w1[l], ffn_w2[l]), norm_ffn_post[l])
    return (xp, xs, jnp.stack(wkv_p), jnp.stack(shift_p), jnp.stack(k_p), jnp.stack(v_p),
            jnp.stack(wkv_s), jnp.stack(shift_s), jnp.stack(k_s), jnp.stack(v_s), jnp.stack(gv_s))
```

```cpp
#include <hip/hip_runtime.h>
#include <cstdio>
#include <cstdint>

namespace pg8 {
#define PG8_LAS __attribute__((address_space(3)))
typedef unsigned short bf16_t;
typedef short bf16x8 __attribute__((ext_vector_type(8)));
typedef float f32x4 __attribute__((ext_vector_type(4)));
typedef unsigned u32x4 __attribute__((ext_vector_type(4)));
constexpr int BM = 256, BK = 64, HALF = 128, HTB = HALF * BK * 2  , STAGE_BYTES = 8 * HTB, NXCD = 8, WGM = 8;

__host__ __device__ __forceinline__ int lds_byte(int r, int c) { const int st = (r >> 4) * 2 + (c >> 5), rr = r & 15, cc = c & 31, ob = rr * 64 + cc * 2; return st * 1024 + (ob ^ (((ob >> 9) & 1) << 5)); }
__host__ __device__ __forceinline__ void stage_rc(int b, int& R, int& C) { const int st = b / 1024, sb = b % 1024, swz = sb ^ (((sb >> 9) & 1) << 5); R = (st >> 1) * 16 + swz / 64; C = (st & 1) * 32 + (swz % 64) / 2; }
__host__ __device__ __forceinline__ int perm32(int rho) { const int n = rho >> 4, i = rho & 15; return 8 * (i >> 2) + 4 * n + (i & 3); }

struct Unit { int pm, pn; };
struct Gemm { const bf16_t* A; const bf16_t* Bt; int M, N, K; };

struct StaticOrder {
    int nM, nN, nwg, G, c;
    __host__ __device__ void init(int M, int N, int G_, int c_) { nM = M / BM; nN = N / BM; nwg = nM * nN; G = G_; c = c_; }
    __host__ __device__ bool next(int i, Unit& u) const {
        const long L = (long)i * G + c; if (L >= nwg) return false;
        int wgid = (int)L; { const int q = nwg / NXCD, r = nwg % NXCD, xcd = wgid % NXCD, off = wgid / NXCD; wgid = (xcd < r ? xcd * (q + 1) : r * (q + 1) + (xcd - r) * q) + off; }
        const int nig = WGM * nN, gid = wgid / nig, fm = gid * WGM, gsz = (nM - fm) < WGM ? (nM - fm) : WGM;
        u.pm = fm + ((wgid % nig) % gsz); u.pn = (wgid % nig) / gsz; return true;
    }
    __device__ __forceinline__ void a_ready(const Unit&) const {}
    __device__ __forceinline__ void done(const Unit&) const {}
};
struct QkvOrder {
    StaticOrder base; int sec_tiles;
    __host__ __device__ void init(int M, int N3, int G_, int c_) { base.init(M, N3, G_, c_); sec_tiles = N3 / BM; }
    __host__ __device__ bool next(int i, Unit& u) const { const int r = i / 3, sct = i % 3; if (!base.next(r, u)) return false; u.pn += sct * sec_tiles; return true; }
    __device__ __forceinline__ void a_ready(const Unit&) const {}
    __device__ __forceinline__ void done(const Unit&) const {}
};

__device__ __forceinline__ unsigned cvt_pk_bf16(float lo, float hi) { unsigned r; asm volatile("v_cvt_pk_bf16_f32 %0, %1, %2" : "=v"(r) : "v"(lo), "v"(hi)); return r; }
typedef float f32x2 __attribute__((ext_vector_type(2)));
__device__ __forceinline__ f32x2 gelu_pk(f32x2 v) {
    const f32x2 av = __builtin_elementwise_abs(v), d = av * 0.2316418882f + 1.0f;
    f32x2 t; t.x = __builtin_amdgcn_rcpf(d.x); t.y = __builtin_amdgcn_rcpf(d.y);
    f32x2 q = t * 0.5307027145f + (-0.7265760135f); q = q * t + 0.7107068705f; q = q * t + (-0.142248368f); q = q * t + 0.127414796f; q = q * t;
    const f32x2 s = (v * v) * (-0.72134752044f);
    f32x2 e; e.x = __builtin_amdgcn_exp2f(s.x); e.y = __builtin_amdgcn_exp2f(s.y);
    const f32x2 m = v * (q * e), r = v - m;
    f32x2 o; o.x = v.x < 0.f ? m.x : r.x; o.y = v.y < 0.f ? m.y : r.y; return o;
}

typedef unsigned u32x2 __attribute__((ext_vector_type(2)));
__device__ __forceinline__ u32x4 pack8(const f32x4 v0, const f32x4 v1) { u32x4 w; w.x = cvt_pk_bf16(v0[0], v0[1]); w.y = cvt_pk_bf16(v0[2], v0[3]); w.z = cvt_pk_bf16(v1[0], v1[1]); w.w = cvt_pk_bf16(v1[2], v1[3]); return w; }
__device__ __forceinline__ unsigned short bf1(float x) { return (unsigned short)(cvt_pk_bf16(x, x) & 0xffffu); }

struct EpiEvenIn {
    static constexpr bool PERM = true, AFTER_DRAIN = false;
    bf16_t* U; bf16_t* VG; bf16_t* PB;
    __device__ __forceinline__ void operator()(const f32x4 (&acc)[2][2][4][2], const Unit& u, int wr, int wc, int fr, int fq) const {
        const int row0 = u.pm * BM + wr * 64 + fr, colb = u.pn * BM + wc * 32 + 8 * fq;
#pragma unroll
        for (int ai = 0; ai < 2; ++ai)
#pragma unroll
            for (int m = 0; m < 4; ++m) { const size_t row = (size_t)(row0 + ai * HALF + m * 16);
#pragma unroll
                for (int bj = 0; bj < 2; ++bj) { const int col = colb + bj * HALF; f32x4 v0 = acc[ai][bj][m][0], v1 = acc[ai][bj][m][1];
                    if (u.pn < 4) {
                        f32x2 a = gelu_pk((f32x2){v0[0], v0[1]}), b = gelu_pk((f32x2){v0[2], v0[3]}), c = gelu_pk((f32x2){v1[0], v1[1]}), d = gelu_pk((f32x2){v1[2], v1[3]});
                        v0 = (f32x4){a.x, a.y, b.x, b.y}; v1 = (f32x4){c.x, c.y, d.x, d.y};
                        bf16_t* dst = (u.pn < 2) ? (U + row * 512 + col) : (VG + row * 512 + (col - 512));
                        *(u32x4*)dst = pack8(v0, v1);
                    } else if (col < 2688) { *(u32x4*)(PB + row * 1664 + (col - 1024)) = pack8(v0, v1); }
                } }
    }
};
struct EpiY16 {
    static constexpr bool PERM = true, AFTER_DRAIN = false;
    bf16_t* Y; int ldc;
    __device__ __forceinline__ void operator()(const f32x4 (&acc)[2][2][4][2], const Unit& u, int wr, int wc, int fr, int fq) const {
        const int row0 = u.pm * BM + wr * 64 + fr, colb = u.pn * BM + wc * 32 + 8 * fq;
#pragma unroll
        for (int ai = 0; ai < 2; ++ai)
#pragma unroll
            for (int m = 0; m < 4; ++m) { bf16_t* rp = Y + (size_t)(row0 + ai * HALF + m * 16) * ldc + colb;
#pragma unroll
                for (int bj = 0; bj < 2; ++bj) *(u32x4*)(rp + bj * HALF) = pack8(acc[ai][bj][m][0], acc[ai][bj][m][1]); }
    }
};
struct EpiF32 {
    static constexpr bool PERM = true, AFTER_DRAIN = false;
    float* Y; int ldc;
    __device__ __forceinline__ void operator()(const f32x4 (&acc)[2][2][4][2], const Unit& u, int wr, int wc, int fr, int fq) const {
        const int row0 = u.pm * BM + wr * 64 + fr, colb = u.pn * BM + wc * 32 + 8 * fq;
#pragma unroll
        for (int ai = 0; ai < 2; ++ai)
#pragma unroll
            for (int m = 0; m < 4; ++m) { float* rp = Y + (size_t)(row0 + ai * HALF + m * 16) * ldc + colb;
#pragma unroll
                for (int bj = 0; bj < 2; ++bj) { *(f32x4*)(rp + bj * HALF) = acc[ai][bj][m][0]; *(f32x4*)(rp + bj * HALF + 4) = acc[ai][bj][m][1]; } }
    }
};
struct EpiRelu2 {
    static constexpr bool PERM = true, AFTER_DRAIN = false;
    bf16_t* O; int ldc;
    __device__ __forceinline__ void operator()(const f32x4 (&acc)[2][2][4][2], const Unit& u, int wr, int wc, int fr, int fq) const {
        const int row0 = u.pm * BM + wr * 64 + fr, colb = u.pn * BM + wc * 32 + 8 * fq;
#pragma unroll
        for (int ai = 0; ai < 2; ++ai)
#pragma unroll
            for (int m = 0; m < 4; ++m) { bf16_t* rp = O + (size_t)(row0 + ai * HALF + m * 16) * ldc + colb;
#pragma unroll
                for (int bj = 0; bj < 2; ++bj) { f32x4 v0 = acc[ai][bj][m][0], v1 = acc[ai][bj][m][1];
#pragma unroll
                    for (int j = 0; j < 4; ++j) { const float a = v0[j] > 0.f ? v0[j] : 0.f, b = v1[j] > 0.f ? v1[j] : 0.f; v0[j] = a * a; v1[j] = b * b; }
                    *(u32x4*)(rp + bj * HALF) = pack8(v0, v1); } }
    }
};
struct EpiQKV {
    static constexpr bool PERM = true, AFTER_DRAIN = false;
    bf16_t* Q; bf16_t* K1; bf16_t* K4; bf16_t* K16; bf16_t* VB;
    float* kp; float* vp; float* ks; float* vs; const float* rope;
    __device__ __forceinline__ void operator()(const f32x4 (&acc)[2][2][4][2], const Unit& u, int wr, int wc, int fr, int fq) const {
        const int sec = u.pn >> 2, row0 = u.pm * BM + wr * 64 + fr, colb = (u.pn & 3) * BM + wc * 32 + 8 * fq;
        const bool ropew = (sec < 2) && ((wc & 1) == 0), prompt = (u.pm < 64);
        const float QS = 0.125f * 1.4426950408889634f;
#pragma unroll
        for (int ai = 0; ai < 2; ++ai)
#pragma unroll
            for (int m = 0; m < 4; ++m) { const int row = row0 + ai * HALF + m * 16;
                const int posidx = prompt ? (row & 2047) : (2048 + ((row - 16384) & 7));
                f32x4 cs0 = {1.f, 0.f, 1.f, 0.f}, cs1 = cs0, cs2 = cs0, cs3 = cs0;
                if (ropew) { const f32x4* rp = (const f32x4*)(rope + (size_t)posidx * 16); cs0 = rp[0]; cs1 = rp[1]; cs2 = rp[2]; cs3 = rp[3]; }
#pragma unroll
                for (int bj = 0; bj < 2; ++bj) { const int col = colb + bj * HALF; f32x4 v0 = acc[ai][bj][m][0], v1 = acc[ai][bj][m][1];
                    if (ropew) {
                        f32x4 o0, o1;
#pragma unroll
                        for (int j = 0; j < 4; ++j) {
                            auto s0 = __builtin_amdgcn_permlane16_swap(__float_as_uint(v0[j]), __float_as_uint(v0[j]), false, false);
                            auto s1 = __builtin_amdgcn_permlane16_swap(__float_as_uint(v1[j]), __float_as_uint(v1[j]), false, false);
                            o0[j] = __uint_as_float((fq & 1) ? s0[0] : s0[1]); o1[j] = __uint_as_float((fq & 1) ? s1[0] : s1[1]); }
                        if (fq < 2) { const float sg = (fq == 0) ? -1.f : 1.f;
                            v0[0] = v0[0] * cs0[0] + sg * o0[0] * cs0[1]; v0[1] = v0[1] * cs0[2] + sg * o0[1] * cs0[3];
                            v0[2] = v0[2] * cs1[0] + sg * o0[2] * cs1[1]; v0[3] = v0[3] * cs1[2] + sg * o0[3] * cs1[3];
                            v1[0] = v1[0] * cs2[0] + sg * o1[0] * cs2[1]; v1[1] = v1[1] * cs2[2] + sg * o1[1] * cs2[3];
                            v1[2] = v1[2] * cs3[0] + sg * o1[2] * cs3[1]; v1[3] = v1[3] * cs3[2] + sg * o1[3] * cs3[3]; }
                    }
                    if (sec == 0) { *(u32x4*)(Q + (size_t)row * 1024 + col) = pack8(v0 * QS, v1 * QS); }
                    else if (sec == 1) {
                        float* p = prompt ? (kp + (size_t)row * 1024 + col) : (ks + (size_t)(row - 16384) * 1024 + col);
                        __builtin_nontemporal_store(v0, (f32x4*)p); __builtin_nontemporal_store(v1, (f32x4*)(p + 4));
                        if (prompt) { const int b = row >> 11, pos = row & 2047, hh = col >> 6, dd = col & 63; const size_t bhh = (size_t)(b * 16 + hh); const u32x4 w = pack8(v0, v1);
                            *(u32x4*)(K1 + (bhh * 2048 + pos) * 64 + dd) = w;
                            *(u32x4*)(K4 + ((bhh * 4 + (pos & 3)) * 512 + (pos >> 2)) * 64 + dd) = w;
                            *(u32x4*)(K16 + ((bhh * 16 + (pos & 15)) * 128 + (pos >> 4)) * 64 + dd) = w; }
                    } else {
                        float* p = prompt ? (vp + (size_t)row * 1024 + col) : (vs + (size_t)(row - 16384) * 1024 + col);
                        __builtin_nontemporal_store(v0, (f32x4*)p); __builtin_nontemporal_store(v1, (f32x4*)(p + 4));
                        if (prompt) *(u32x4*)(VB + (size_t)row * 1024 + col) = pack8(v0, v1);
                    }
                } }
    }
};

template <class Epi, class Sched, bool ALIGN_EPI = false, bool SP2 = false>
__device__ __forceinline__ void gemm_phase(PG8_LAS unsigned char* lds, const Gemm g, const Sched& S, const Epi& E) {
    const int tid = threadIdx.x, wid = __builtin_amdgcn_readfirstlane(tid >> 6), lane = tid & 63, wr = wid >> 2, wc = wid & 3, fr = lane & 15, fq = lane >> 4;
    const int K = g.K, nt = K / BK;
    unsigned voffA[2], voffB[2];
#pragma unroll
    for (int i = 0; i < 2; ++i) { int R, C; stage_rc(tid * 16 + i * 8192, R, C); const int Rb = Epi::PERM ? ((R & ~31) + perm32(R & 31)) : R;
        voffA[i] = (unsigned)(R * K + C) * 2u; voffB[i] = (unsigned)(Rb * K + C) * 2u; }
    const size_t kstep = (size_t)(BK * 2);
    const size_t hstep = (size_t)HALF * K * 2;
    const size_t tstep = 2 * hstep;
    const unsigned ldsw = (unsigned)wid * 1024u;
    const int aoff = lds_byte(wr * 64 + fr, fq * 8), boff = lds_byte(wc * 32 + fr, fq * 8);
#define PG8_SA(b, h) (((b) * 2 + (h)) * HTB)
#define PG8_SB(b, h) ((4 + (b) * 2 + (h)) * HTB)
#define PG8_STAGE(bufoff, gbase, voff) do { _Pragma("unroll") for (int _i = 0; _i < 2; ++_i) \
        __builtin_amdgcn_global_load_lds((const unsigned*)((const char*)(gbase) + (voff)[_i]), (PG8_LAS unsigned*)(lds + (bufoff) + ldsw + _i * 8192), 16, 0, 0); } while (0)
#define PG8_LDA(dst, b, h) do { _Pragma("unroll") for (int m = 0; m < 4; ++m) _Pragma("unroll") for (int k = 0; k < 2; ++k) dst[m][k] = *(const PG8_LAS bf16x8*)(lds + PG8_SA(b, h) + aoff + m * 2048 + k * 1024); } while (0)
#define PG8_LDB(dst, b, h) do { _Pragma("unroll") for (int n = 0; n < 2; ++n) _Pragma("unroll") for (int k = 0; k < 2; ++k) dst[n][k] = *(const PG8_LAS bf16x8*)(lds + PG8_SB(b, h) + boff + n * 2048 + k * 1024); } while (0)
#define PG8_MMA(ai, bj, At, Bt) do { __builtin_amdgcn_s_setprio(1); _Pragma("unroll") for (int m = 0; m < 4; ++m) _Pragma("unroll") for (int n = 0; n < 2; ++n) _Pragma("unroll") for (int k = 0; k < 2; ++k) \
        acc[ai][bj][m][n] = __builtin_amdgcn_mfma_f32_16x16x32_bf16(Bt[n][k], At[m][k], acc[ai][bj][m][n], 0, 0, 0); __builtin_amdgcn_s_setprio(0); } while (0)
#define PG8_WAIT_V(n) asm volatile("s_waitcnt vmcnt(" #n ")" ::: "memory")
#define PG8_WAIT_L(n) asm volatile("s_waitcnt lgkmcnt(" #n ")" ::: "memory")
#define PG8_BAR __builtin_amdgcn_s_barrier()
#define PG8_SCHED __builtin_amdgcn_sched_barrier(0)
    Unit cur, nxt; int ui = 0;
    if (!S.next(0, cur)) return;
    f32x4 acc[2][2][4][2];
#pragma unroll
    for (int a = 0; a < 2; ++a)
#pragma unroll
        for (int b = 0; b < 2; ++b)
#pragma unroll
            for (int m = 0; m < 4; ++m)
#pragma unroll
                for (int n = 0; n < 2; ++n) acc[a][b][m][n] = (f32x4){0.f, 0.f, 0.f, 0.f};
    bf16x8 At[4][2], B0[2][2], B1[2][2];
    const char* cA = (const char*)g.A + (size_t)cur.pm * tstep; const char* cB = (const char*)g.Bt + (size_t)cur.pn * tstep;
    S.a_ready(cur);
    if constexpr (SP2) {
        PG8_STAGE(PG8_SB(0, 0), cB, voffB); PG8_STAGE(PG8_SB(0, 1), cB + hstep, voffB); PG8_STAGE(PG8_SA(0, 0), cA, voffA); PG8_STAGE(PG8_SA(0, 1), cA + hstep, voffA);
        if (wr == 1) PG8_BAR;
        PG8_WAIT_V(2); PG8_BAR;
        PG8_STAGE(PG8_SB(1, 0), cB + kstep, voffB); PG8_STAGE(PG8_SA(1, 0), cA + kstep, voffA); PG8_STAGE(PG8_SB(1, 1), cB + hstep + kstep, voffB);
        PG8_WAIT_V(6); PG8_BAR;
    } else {
        PG8_STAGE(PG8_SB(0, 0), cB, voffB); PG8_STAGE(PG8_SA(0, 0), cA, voffA); PG8_STAGE(PG8_SB(0, 1), cB + hstep, voffB); PG8_STAGE(PG8_SA(0, 1), cA + hstep, voffA);
        if (wr == 1) PG8_BAR;
        PG8_WAIT_V(4); PG8_BAR;
        PG8_STAGE(PG8_SB(1, 0), cB + kstep, voffB); PG8_STAGE(PG8_SA(1, 0), cA + kstep, voffA); PG8_STAGE(PG8_SB(1, 1), cB + hstep + kstep, voffB);
        PG8_WAIT_V(6); PG8_BAR;
    }
    for (;;) {
        const bool has_next = S.next(ui + 1, nxt);
        const char* nA = has_next ? (const char*)g.A + (size_t)nxt.pm * tstep : cA; const char* nB = has_next ? (const char*)g.Bt + (size_t)nxt.pn * tstep : cB;
        for (int t = 0; t < nt; t += 2) {
            const bool last = (t == nt - 2);
            const char* a1 = cA + (size_t)(t + 1) * kstep;
            const char* a2 = last ? nA : cA + (size_t)(t + 2) * kstep; const char* b2 = last ? nB : cB + (size_t)(t + 2) * kstep;
            const char* a3 = a2 + kstep; const char* b3 = b2 + kstep;
            if (last && has_next) S.a_ready(nxt);
            if constexpr (SP2) {
            PG8_LDB(B0, 0, 0); PG8_LDB(B1, 0, 1); PG8_SCHED; PG8_LDA(At, 0, 0); PG8_STAGE(PG8_SA(1, 1), a1 + hstep, voffA);
            PG8_WAIT_V(8); PG8_WAIT_L(0); PG8_BAR; PG8_MMA(0, 0, At, B0); PG8_MMA(0, 1, At, B1); PG8_BAR; PG8_SCHED;
            PG8_LDA(At, 0, 1); PG8_STAGE(PG8_SB(0, 0), b2, voffB); PG8_STAGE(PG8_SB(0, 1), b2 + hstep, voffB); PG8_STAGE(PG8_SA(0, 0), a2, voffA);
            PG8_WAIT_V(8); PG8_WAIT_L(0); PG8_BAR; PG8_MMA(1, 0, At, B0); PG8_MMA(1, 1, At, B1); PG8_BAR; PG8_SCHED;
            PG8_LDB(B0, 1, 0); PG8_LDB(B1, 1, 1); PG8_SCHED; PG8_LDA(At, 1, 0); PG8_STAGE(PG8_SA(0, 1), a2 + hstep, voffA);
            PG8_WAIT_V(8); PG8_WAIT_L(0); PG8_BAR; PG8_MMA(0, 0, At, B0); PG8_MMA(0, 1, At, B1); PG8_BAR; PG8_SCHED;
            PG8_LDA(At, 1, 1); PG8_STAGE(PG8_SB(1, 0), b3, voffB); PG8_STAGE(PG8_SB(1, 1), b3 + hstep, voffB); PG8_STAGE(PG8_SA(1, 0), a3, voffA);
            PG8_WAIT_V(8); PG8_WAIT_L(0); PG8_BAR; PG8_MMA(1, 0, At, B0); PG8_MMA(1, 1, At, B1); PG8_BAR; PG8_SCHED;
            } else {
            PG8_LDB(B0, 0, 0); PG8_SCHED; PG8_LDA(At, 0, 0); PG8_STAGE(PG8_SA(1, 1), a1 + hstep, voffA);
            PG8_WAIT_L(8); PG8_BAR; PG8_WAIT_L(0); PG8_MMA(0, 0, At, B0); PG8_BAR; PG8_SCHED;
            PG8_LDB(B1, 0, 1); PG8_STAGE(PG8_SB(0, 0), b2, voffB);
            PG8_BAR; PG8_WAIT_L(0); PG8_MMA(0, 1, At, B1); PG8_BAR;
            PG8_LDA(At, 0, 1); PG8_STAGE(PG8_SA(0, 0), a2, voffA);
            PG8_BAR; PG8_WAIT_L(0); PG8_MMA(1, 0, At, B0); PG8_BAR; PG8_SCHED;
            PG8_STAGE(PG8_SB(0, 1), b2 + hstep, voffB);
            PG8_WAIT_V(6); PG8_BAR; PG8_MMA(1, 1, At, B1); PG8_BAR;
            PG8_LDB(B0, 1, 0); PG8_SCHED; PG8_LDA(At, 1, 0); PG8_STAGE(PG8_SA(0, 1), a2 + hstep, voffA);
            PG8_WAIT_L(8); PG8_BAR; PG8_WAIT_L(0); PG8_MMA(0, 0, At, B0); PG8_BAR; PG8_SCHED;
            PG8_LDB(B1, 1, 1); PG8_STAGE(PG8_SB(1, 0), b3, voffB);
            PG8_BAR; PG8_WAIT_L(0); PG8_MMA(0, 1, At, B1); PG8_BAR;
            PG8_LDA(At, 1, 1); PG8_STAGE(PG8_SA(1, 0), a3, voffA);
            PG8_BAR; PG8_WAIT_L(0); PG8_MMA(1, 0, At, B0); PG8_BAR; PG8_SCHED;
            PG8_STAGE(PG8_SB(1, 1), b3 + hstep, voffB);
            PG8_WAIT_V(6); PG8_BAR; PG8_MMA(1, 1, At, B1); PG8_BAR;
            }
        }
        if constexpr (ALIGN_EPI) { if (wr == 0) PG8_BAR; }
        if constexpr (!Epi::AFTER_DRAIN) { E(acc, cur, wr, wc, fr, fq); S.done(cur); }
        if (!has_next) break;
#pragma unroll
        for (int a = 0; a < 2; ++a)
#pragma unroll
            for (int b = 0; b < 2; ++b)
#pragma unroll
                for (int m = 0; m < 4; ++m)
#pragma unroll
                    for (int n = 0; n < 2; ++n) acc[a][b][m][n] = (f32x4){0.f, 0.f, 0.f, 0.f};
        cur = nxt; cA = nA; cB = nB; ++ui;
        if constexpr (ALIGN_EPI) { if (wr == 1) PG8_BAR; }
    }
    PG8_WAIT_V(0);
    if constexpr (!ALIGN_EPI) { if (wr == 0) PG8_BAR; }
    PG8_BAR;
    if constexpr (Epi::AFTER_DRAIN) { E.fused(acc, cur, wr, wc, fr, fq, lds, wid, lane); S.done(cur); }
#undef PG8_SA
#undef PG8_SB
#undef PG8_STAGE
#undef PG8_LDA
#undef PG8_LDB
#undef PG8_MMA
#undef PG8_WAIT_V
#undef PG8_WAIT_L
#undef PG8_BAR
#undef PG8_SCHED
}
}

#ifndef PG8_SP2
#define PG8_SP2 true
#endif
#ifndef PG8_ALIGN
#define PG8_ALIGN true
#endif
#ifndef PROBE_DUP_MASK
#define PROBE_DUP_MASK 0
#endif
#ifndef MK_PER_PHASE
#define MK_PER_PHASE 0
#endif

constexpr int NWAVES = 8;
constexpr int D = 1024, DFF = 4096, MP = 16384, MS = 256, M = MP + MS, SEQ = 2048, NB = 8, NSB = 32, DSEQ = 8, DEPTH = 4;
constexpr int EVEN_IN = 2688, EVEN_IN_PAD = 2816, BCOLS = 1664, AW = 512, BW = 512, NROWC = NB + NSB  ;
constexpr float NORM_EPS = 1e-6f, LN_EPS = 1e-5f, GN_EPS = 64e-5f;
enum { I_XP = 0, I_XS, I_SWKV, I_SSHIFT, I_CK, I_CV, I_CP, I_CS, I_ADAW, I_ADAB, I_NMPRE, I_NMPOST, I_NFPRE, I_NFPOST, I_W1, I_W2, I_EVIN, I_EVOUT,
       I_LNG, I_LNB, I_WS, I_BS, I_MU, I_W0, I_RW2, I_A0, I_A2, I_G2, I_KK, I_KA, I_RK, I_LNXG, I_LNXB, I_QKV, I_ODOUT, N_IN };
constexpr size_t O_YP = 0, O_YS = O_YP + (size_t)MP * D, O_WKVP = O_YS + (size_t)MS * D, O_SHP = O_WKVP + 2ull * 8 * 8 * 64 * 64, O_KP = O_SHP + 2ull * 8 * BCOLS,
                 O_VP = O_KP + 2ull * MP * D, O_WKVS = O_VP + 2ull * MP * D, O_SHS = O_WKVS + 2ull * 32 * 8 * 64 * 64, O_KS = O_SHS + 2ull * 32 * BCOLS,
                 O_VS = O_KS + 2ull * MS * D, O_GV = O_VS + 2ull * MS * D, O_END = O_GV + 2ull * MS * AW;
static_assert(O_END == 88213504ull, "output size");

constexpr size_t MiB = 1u << 20;
constexpr size_t WS_CTL = 0, CTL_ZERO_BYTES = 64 * 1024;
constexpr size_t WS_MODS = 2 * MiB;
constexpr size_t WS_ROPE = 6 * MiB;
constexpr size_t WS_TRIL = 7 * MiB;
constexpr size_t WS_W1T = 8 * MiB, WS_W2T = 40 * MiB, WS_WINT = 72 * MiB, WS_WOUTT = 83 * MiB, WS_WQKVT = 87 * MiB, WS_WOT = 99 * MiB;
constexpr size_t WS_HB = 128 * MiB;
constexpr size_t WS_MIX = 161 * MiB;
constexpr size_t WS_Y = 194 * MiB;
constexpr size_t WS_FF = 259 * MiB;
constexpr size_t WS_U = 389 * MiB, WS_VG = 406 * MiB;
constexpr size_t WS_PB = 423 * MiB;
constexpr size_t WS_RW = 529 * MiB;
constexpr size_t WS_DEC = 640 * MiB;
constexpr size_t WS_G = 724 * MiB;
constexpr size_t WS_BON = 757 * MiB;
constexpr size_t WS_OSC = 760 * MiB;
constexpr size_t WS_Q = 389 * MiB, WS_K = 422 * MiB, WS_VT1 = 454 * MiB, WS_VT4 = 486 * MiB, WS_VT16 = 518 * MiB;
constexpr size_t WS_VB = 550 * MiB;
constexpr size_t WS_K4 = 582 * MiB, WS_K16 = 614 * MiB;
constexpr size_t WS_X16 = 794 * MiB;
constexpr size_t WS_END = 828 * MiB;
static_assert(WS_MODS + 4ull * 40 * 6144 * 4 <= WS_ROPE && WS_WOT + 2ull * D * D * 2 <= WS_HB && WS_HB + (size_t)M * D * 2 <= WS_MIX && WS_MIX + (size_t)M * D * 2 <= WS_Y &&
              WS_Y + (size_t)M * D * 4 <= WS_FF && WS_FF + (size_t)M * DFF * 2 <= WS_U && WS_U + (size_t)M * 512 * 2 <= WS_VG && WS_VG + (size_t)M * 512 * 2 <= WS_PB &&
              WS_PB + (size_t)M * BCOLS * 4 <= WS_RW && WS_RW + (size_t)M * 2560 * 2 <= WS_DEC && WS_DEC + (size_t)M * 512 * 4 <= WS_G && WS_G + (size_t)M * 512 * 4 <= WS_BON && WS_BON + (size_t)M * 8 * 16 <= WS_OSC &&
              WS_OSC + (size_t)M * 512 * 4 <= WS_X16 && WS_X16 + (size_t)M * D * 2 <= WS_END && WS_Q + (size_t)M * D * 2 <= WS_K && WS_K + (size_t)MP * D * 2 == WS_VT1 && WS_VT16 + (size_t)MP * D * 2 <= WS_END, "d_ws map");
constexpr int CW_TMO = 0, CW_BAR = 4096;
static_assert((CW_BAR + 3456  ) * 4 <= (int)CTL_ZERO_BYTES, "barrier words inside the memset region");

constexpr int RING_BYTES = 131072, LDSCTL_OFF = RING_BYTES, MISC_OFF = LDSCTL_OFF + 320, LDS_BYTES = 147456;

#define GAS __attribute__((address_space(1)))
#define LAS __attribute__((address_space(3)))
typedef unsigned short bf16;
typedef unsigned v4u __attribute__((ext_vector_type(4)));
typedef unsigned v2u __attribute__((ext_vector_type(2)));
typedef float f32x4 __attribute__((ext_vector_type(4)));
typedef float f32x2 __attribute__((ext_vector_type(2)));
typedef short bf16x8 __attribute__((ext_vector_type(8)));
typedef GAS unsigned gu32;
#define RLX_AGENT __ATOMIC_RELAXED, __HIP_MEMORY_SCOPE_AGENT
#define LDS_WAIT() asm volatile("s_waitcnt lgkmcnt(0)" ::: "memory")
typedef __bf16 bf16x2_hw __attribute__((ext_vector_type(2)));
__device__ __forceinline__ unsigned pk2(float lo, float hi) { const f32x2 v = {lo, hi}; const bf16x2_hw b = __builtin_convertvector(v, bf16x2_hw); return __builtin_bit_cast(unsigned, b); }
__device__ __forceinline__ unsigned f2bf(float f) { return pk2(f, f) & 0xffffu; }
__device__ __forceinline__ float bf2f(unsigned short h) { return __builtin_bit_cast(float, (unsigned)h << 16); }
__device__ __forceinline__ float bflo(unsigned w) { return __builtin_bit_cast(float, w << 16); }
__device__ __forceinline__ float bfhi(unsigned w) { return __builtin_bit_cast(float, w & 0xffff0000u); }
template <int CTRL> __device__ __forceinline__ float dpp(float x) { return __builtin_bit_cast(float, __builtin_amdgcn_mov_dpp(__builtin_bit_cast(int, x), CTRL, 0xf, 0xf, true)); }
constexpr int XOR1 = 0xB1, XOR2 = 0x4E, XOR8 = 0x128, ROR4 = 0x124;
__device__ __forceinline__ float row16_sum(float x) { x += dpp<XOR1>(x); x += dpp<XOR2>(x); x += dpp<ROR4>(x); x += dpp<XOR8>(x); return x; }
__device__ __forceinline__ float xrow16_sum(float x) {
    auto s = __builtin_amdgcn_permlane16_swap(__float_as_uint(x), __float_as_uint(x), false, false); x = __uint_as_float(s[0]) + __uint_as_float(s[1]);
    auto t = __builtin_amdgcn_permlane32_swap(__float_as_uint(x), __float_as_uint(x), false, false); return __uint_as_float(t[0]) + __uint_as_float(t[1]); }
__device__ __forceinline__ float xrow16_max(float x) {
    auto s = __builtin_amdgcn_permlane16_swap(__float_as_uint(x), __float_as_uint(x), false, false); x = fmaxf(__uint_as_float(s[0]), __uint_as_float(s[1]));
    auto t = __builtin_amdgcn_permlane32_swap(__float_as_uint(x), __float_as_uint(x), false, false); return fmaxf(__uint_as_float(t[0]), __uint_as_float(t[1])); }
__device__ __forceinline__ float wave_sum(float x) { return xrow16_sum(row16_sum(x)); }

struct Args { const float* in[N_IN]; float* out; unsigned char* ws; int ph_lo, ph_hi; };
static_assert(sizeof(Args) == N_IN * 8 + 24, "Args has no padding");

#define XB_TMO      128
#define XB_XCNT(j)  (256  + 64 * (j))
#define XB_XSUB(j)  (1280 + 64 * (j))
#define XB_XGEN(j)  (2304 + 64 * (j))
#define XB_TOP      3328
#define XB_TOPGEN   3392
#define XCD_BAR_WORDS 3456
#define XB_SPIN_CAP (1u << 18)

__device__ __forceinline__ unsigned xb_ld(unsigned* p)              { return __hip_atomic_load(p, __ATOMIC_RELAXED, __HIP_MEMORY_SCOPE_AGENT); }
__device__ __forceinline__ unsigned xb_add(unsigned* p, unsigned v) { return __hip_atomic_fetch_add(p, v, __ATOMIC_RELAXED, __HIP_MEMORY_SCOPE_AGENT); }
__device__ __forceinline__ unsigned xb_xcc_id() { return (unsigned)__builtin_amdgcn_s_getreg((3 << 11) | 20) & 0xFu; }
#define XB_SPIN(cond, bar) do { unsigned _sp = 0; while (cond) { __builtin_amdgcn_s_sleep(1); \
    if ((++_sp & 255u) == 0u) { if (xb_ld(&(bar)[XB_TMO])) break; if (_sp > XB_SPIN_CAP) { atomicAdd(&(bar)[XB_TMO], 1u); break; } } } } while (0)

struct XcdBarrier {
    unsigned* bar; unsigned x;
    volatile LAS unsigned* st;
};

__device__ __forceinline__ XcdBarrier xcd_barrier_post(unsigned* bar, volatile LAS unsigned* st) {
    XcdBarrier b; b.bar = bar; b.x = xb_xcc_id(); b.st = st;
    if (threadIdx.x == 0) (void)xb_add(&bar[XB_XCNT(b.x)], 1u);
    return b;
}
__device__ __forceinline__ void xcd_barrier_complete(unsigned* bar, unsigned x, unsigned& nloc, unsigned& nx) {
    const unsigned G = gridDim.x * gridDim.y * gridDim.z;
    unsigned sum, cnt, mine, sp = 0u;
    for (;;) {
        sum = 0u; cnt = 0u; mine = 0u;
#pragma unroll
        for (unsigned j = 0; j < 16; ++j) { const unsigned c = xb_ld(&bar[XB_XCNT(j)]); sum += c; cnt += (c > 0u) ? 1u : 0u; mine = (j == x) ? c : mine; }
        if (sum == G) break;
        __builtin_amdgcn_s_sleep(1);
        if ((++sp & 255u) == 0u) { if (xb_ld(&bar[XB_TMO])) break; if (sp > XB_SPIN_CAP) { atomicAdd(&bar[XB_TMO], 1u); break; } }
    }
    nloc = mine > 0u ? mine : 1u; nx = cnt > 0u ? cnt : 1u;
}

__device__ __forceinline__ void xcd_barrier(const XcdBarrier& b) {
    asm volatile("s_waitcnt vmcnt(0)" ::: "memory");
    __syncthreads();
    if (threadIdx.x == 0) {
        unsigned* bar = b.bar;
        __builtin_amdgcn_s_waitcnt(0);
        unsigned nloc = b.st[0], nx = b.st[1];
        if (nloc == 0u) { xcd_barrier_complete(bar, b.x, nloc, nx); b.st[0] = nloc; b.st[1] = nx; }
        const unsigned old = xb_add(&bar[XB_XSUB(b.x)], 1u);
        const unsigned gen = old / nloc;
        if (old + 1u == (gen + 1u) * nloc) {
            __builtin_amdgcn_fence(__ATOMIC_RELEASE, "agent");
            asm volatile("s_waitcnt vmcnt(0)" ::: "memory");
            const unsigned og = xb_add(&bar[XB_TOP], 1u);
            const unsigned tg = og / nx;
            if (og + 1u == (tg + 1u) * nx) xb_add(&bar[XB_TOPGEN], 1u);
            else XB_SPIN(xb_ld(&bar[XB_TOPGEN]) == tg, bar);
            __builtin_amdgcn_fence(__ATOMIC_ACQUIRE, "agent");
            xb_add(&bar[XB_XGEN(b.x)], 1u);
            asm volatile("s_waitcnt vmcnt(0)" ::: "memory");
        } else {
            XB_SPIN(xb_ld(&bar[XB_XGEN(b.x)]) == gen, bar);
            __builtin_amdgcn_fence(__ATOMIC_ACQUIRE, "agent");
            asm volatile("s_waitcnt vmcnt(0)" ::: "memory");
        }
    }
    __syncthreads();
}

struct Frame {
    LAS unsigned char* lds;
    volatile LAS unsigned* MISC;
    gu32* ctl;
    int tid, lane, wave, vcu, G;
};

__device__ __forceinline__ void p0_transpose_item(const float* W, int K, int N, bf16* WT, LAS float* scr, int item, int lane) {
    const int nblk = N / 32, kb = item / nblk, nb = item % nblk, k0 = 64 * kb, n0 = 32 * nb;
    float tv[32];
#pragma unroll
    for (int i = 0; i < 32; ++i) { const int kk = 2 * i + (lane >> 5); tv[i] = W[(size_t)(k0 + kk) * N + n0 + (lane & 31)]; }
    __builtin_amdgcn_sched_barrier(0);
#pragma unroll
    for (int i = 0; i < 32; ++i) { const int kk = 2 * i + (lane >> 5); scr[kk * 33 + (lane & 31)] = tv[i]; }
    LDS_WAIT(); asm volatile("" ::: "memory");
    const int c = lane & 7;
#pragma unroll
    for (int j = 0; j < 4; ++j) { const int n = (lane >> 3) + 8 * j; const LAS float* s = scr + (8 * c) * 33 + n;
        v4u o; o.x = pk2(s[0 * 33], s[1 * 33]); o.y = pk2(s[2 * 33], s[3 * 33]); o.z = pk2(s[4 * 33], s[5 * 33]); o.w = pk2(s[6 * 33], s[7 * 33]);
        *(GAS v4u*)(WT + (size_t)(n0 + n) * K + k0 + 8 * c) = o; }
    LDS_WAIT(); asm volatile("" ::: "memory");
}
__device__ __forceinline__ void rope_cs(int pos, int i, float& c, float& s) {
    double b = __builtin_sqrt(__builtin_sqrt(__builtin_sqrt(500000.0))); b = 1.0 / b;
    double inv = 1.0; for (int j = 0; j < i; ++j) inv *= b;
    const double ang = (double)pos * inv;
    const double TWO_PI = 6.283185307179586476925286766559, HALF_PI = 1.5707963267948966192313216916398;
    double r = ang - TWO_PI * __builtin_rint(ang / TWO_PI);
    const double qd = __builtin_rint(r / HALF_PI); const int q = (int)qd; const double y = r - qd * HALF_PI, y2 = y * y;
    const double sy = y * (1.0 + y2 * (-1.0 / 6 + y2 * (1.0 / 120 + y2 * (-1.0 / 5040 + y2 * (1.0 / 362880 + y2 * (-1.0 / 39916800 + y2 * (1.0 / 6227020800.0)))))));
    const double cy = 1.0 + y2 * (-0.5 + y2 * (1.0 / 24 + y2 * (-1.0 / 720 + y2 * (1.0 / 40320 + y2 * (-1.0 / 3628800 + y2 * (1.0 / 479001600.0 + y2 * (-1.0 / 87178291200.0)))))));
    const int qq = q & 3; double cc, ss;
    if (qq == 0) { cc = cy; ss = sy; } else if (qq == 1) { cc = -sy; ss = cy; } else if (qq == 2) { cc = -cy; ss = -sy; } else { cc = sy; ss = -cy; }
    c = (float)cc; s = (float)ss;
}
__device__ __forceinline__ void p0_prologue(const Args& A, Frame& F) {
    const int tid = F.tid, lane = F.lane, wave = F.wave;
    constexpr int CP = 2064;
    for (int idx = tid; idx < 48 * 512; idx += NWAVES * 64) { const int n = idx >> 9, k2 = (idx & 511) * 2; unsigned w = 0u;
        if (n < NROWC) { const float* src = (n < NB) ? (A.in[I_CP] + (size_t)n * D) : (A.in[I_CS] + (size_t)(n - NB) * D);
            const float a = src[k2], b = src[k2 + 1]; w = pk2(a / (1.f + __expf(-a)), b / (1.f + __expf(-b))); }
        *(LAS unsigned*)(F.lds + n * CP + k2 * 2) = w; }
    __syncthreads();
    if (wave < 6) {
        const int job = wave * 256 + F.vcu;
        if (job < 1536) {
            const int l = job / 384, jt = job % 384, j = lane & 15, g = lane >> 4;
            const float* W = A.in[I_ADAW] + (size_t)l * D * 6144 + 16 * jt + j;
            f32x4 acc[3]; acc[0] = acc[1] = acc[2] = (f32x4){0.f, 0.f, 0.f, 0.f};
#pragma unroll 1
            for (int s0 = 0; s0 < 32; s0 += 8) {
                float a[8][8];
#pragma unroll
                for (int u = 0; u < 8; ++u)
#pragma unroll
                    for (int e = 0; e < 8; ++e) a[u][e] = W[(size_t)(32 * (s0 + u) + 8 * g + e) * 6144];
                __builtin_amdgcn_sched_barrier(0);
#pragma unroll
                for (int u = 0; u < 8; ++u) { const int s = s0 + u;
                    v4u af; af.x = pk2(a[u][0], a[u][1]); af.y = pk2(a[u][2], a[u][3]); af.z = pk2(a[u][4], a[u][5]); af.w = pk2(a[u][6], a[u][7]);
                    const bf16x8 Afr = __builtin_bit_cast(bf16x8, af);
#pragma unroll
                    for (int nt = 0; nt < 3; ++nt) { const bf16x8 B = *(const LAS bf16x8*)(F.lds + (16 * nt + j) * CP + (32 * s + 8 * g) * 2);
                        acc[nt] = __builtin_amdgcn_mfma_f32_16x16x32_bf16(Afr, B, acc[nt], 0, 0, 0); } }
            }
            const f32x4 bias = *(const f32x4*)(A.in[I_ADAB] + (size_t)l * 6144 + 16 * jt + 4 * g);
            float* mods = (float*)(A.ws + WS_MODS);
#pragma unroll
            for (int nt = 0; nt < 3; ++nt) { const int n = 16 * nt + j; if (n < NROWC) *(f32x4*)(mods + ((size_t)l * NROWC + n) * 6144 + 16 * jt + 4 * g) = acc[nt] + bias; }
        }
    }
    __syncthreads();
    {
        LAS float* scr = (LAS float*)(F.lds + wave * 16384);
        const int gw = F.vcu * NWAVES + wave, NGW = F.G * NWAVES;
        constexpr int I_FF = (D / 64) * (DFF / 32);
        constexpr int I_IN = (D / 64) * (EVEN_IN / 32);
        constexpr int I_SQ = (D / 64) * (D / 32);
        constexpr int I_QK = (D / 64) * (3 * D / 32);
        constexpr int NITEMS = 8 * I_FF + 2 * (I_IN + I_SQ + I_QK + I_SQ);
        for (int it = gw; it < NITEMS; it += NGW) {
            int r = it;
            if (r < 4 * I_FF) { const int l = r / I_FF; p0_transpose_item(A.in[I_W1] + (size_t)l * D * DFF, D, DFF, (bf16*)(A.ws + WS_W1T) + (size_t)l * D * DFF, scr, r % I_FF, lane); continue; } r -= 4 * I_FF;
            if (r < 4 * I_FF) { const int l = r / I_FF; p0_transpose_item(A.in[I_W2] + (size_t)l * D * DFF, DFF, D, (bf16*)(A.ws + WS_W2T) + (size_t)l * D * DFF, scr, r % I_FF, lane); continue; } r -= 4 * I_FF;
            if (r < 2 * I_IN) { const int e = r / I_IN; p0_transpose_item(A.in[I_EVIN] + (size_t)e * D * EVEN_IN, D, EVEN_IN, (bf16*)(A.ws + WS_WINT) + (size_t)e * EVEN_IN_PAD * D, scr, r % I_IN, lane); continue; } r -= 2 * I_IN;
            if (r < 2 * I_SQ) { const int e = r / I_SQ; p0_transpose_item(A.in[I_EVOUT] + (size_t)e * D * D, D, D, (bf16*)(A.ws + WS_WOUTT) + (size_t)e * D * D, scr, r % I_SQ, lane); continue; } r -= 2 * I_SQ;
            if (r < 2 * I_QK) { const int o = r / I_QK; p0_transpose_item(A.in[I_QKV] + (size_t)o * D * 3 * D, D, 3 * D, (bf16*)(A.ws + WS_WQKVT) + (size_t)o * 3 * D * D, scr, r % I_QK, lane); continue; } r -= 2 * I_QK;
            { const int o = r / I_SQ; p0_transpose_item(A.in[I_ODOUT] + (size_t)o * D * D, D, D, (bf16*)(A.ws + WS_WOT) + (size_t)o * D * D, scr, r % I_SQ, lane); }
        }
    }
    const int gt = F.vcu * (NWAVES * 64) + tid, NGT = F.G * NWAVES * 64;
    for (int i = gt; i < 2 * 128 * 1024 / 8; i += NGT) { const int e = i / (128 * 128), r = i % (128 * 128);
        *(v4u*)((bf16*)(A.ws + WS_WINT) + (size_t)e * EVEN_IN_PAD * D + (size_t)EVEN_IN * D + (size_t)r * 8) = (v4u){0u, 0u, 0u, 0u}; }
    for (int i = gt; i < 2 * 4 * 128 * 128; i += NGT) { const int ii = (i >> 7) & 127, jj = i & 127; ((bf16*)(A.ws + WS_TRIL))[i] = (jj <= ii) ? (bf16)f2bf(A.in[I_WS][i]) : (bf16)0; }
    for (int i = gt; i < 2056 * 8; i += NGT) { const int p = i >> 3, k = i & 7; const int pos = (p < 2048) ? p : (8192 + (p - 2048)); float c, s; rope_cs(pos, k, c, s);
        ((float*)(A.ws + WS_ROPE))[2 * i] = c; ((float*)(A.ws + WS_ROPE))[2 * i + 1] = s; }
}

template <int MODE> __device__ __forceinline__ void norm_phase(const Args& A, Frame& F, int l) {
    const int gw = F.vcu * NWAVES + F.wave, NGW = F.G * NWAVES, lane = F.lane;
    bf16* X = (bf16*)(A.ws + WS_X16); const bf16* Y = (const bf16*)(A.ws + WS_Y); bf16* HB = (bf16*)(A.ws + WS_HB); const float* mods = (const float*)(A.ws + WS_MODS);
    const int lh = (MODE == 2) ? l + 1 : l;
    const bool do_h = (MODE != 2) || (l + 1 < DEPTH);
    const float* gpost = (MODE == 1) ? (A.in[I_NMPOST] + (size_t)l * D) : (A.in[I_NFPOST] + (size_t)l * D);
    const float* gpre = (MODE == 1) ? (A.in[I_NFPRE] + (size_t)lh * D) : (A.in[I_NMPRE] + (size_t)(do_h ? lh : 0) * D);
    const int gate_i = (MODE == 1) ? 2 : 5, shift_i = (MODE == 1) ? 3 : 0, scale_i = (MODE == 1) ? 4 : 1;
    const bool affine = (F.G == 256);
    const int nit = affine ? 9 : (M - gw + NGW - 1) / NGW;
    for (int it = 0; it < nit; ++it) {
        int m;
        if (affine) { if (it < 8) m = 64 * F.vcu + F.wave + 8 * it; else { if (F.wave != (F.vcu & 7)) break; m = MP + F.vcu; } }
        else m = gw + it * NGW;
        const int n = (m < MP) ? (m >> 11) : (NB + ((m - MP) >> 3));
        f32x4 x[4];
        if (MODE == 0) {
            const f32x4* src = (const f32x4*)((m < MP) ? (A.in[I_XP] + (size_t)m * D) : (A.in[I_XS] + (size_t)(m - MP) * D)) + lane;
#pragma unroll
            for (int j = 0; j < 4; ++j) x[j] = src[64 * j];
        } else {
            const v2u* yr = (const v2u*)(Y + (size_t)m * D) + lane; const v2u* xr = (const v2u*)(X + (size_t)m * D) + lane;
            const f32x4* gt = (const f32x4*)(mods + ((size_t)l * NROWC + n) * 6144 + gate_i * D) + lane; const f32x4* gp = (const f32x4*)gpost + lane;
            f32x4 y[4]; float ss = 0.f;
#pragma unroll
            for (int j = 0; j < 4; ++j) {
                if (MODE == 2 && m >= MP) {
                    const f32x4* pr = (const f32x4*)((const float*)(A.ws + WS_OSC) + (size_t)(m - MP) * D) + lane + 64 * j;
                    y[j] = (pr[0] + pr[65536]) + (pr[131072] + pr[196608]);
                } else { const v2u yw = yr[64 * j]; y[j] = (f32x4){bflo(yw.x), bfhi(yw.x), bflo(yw.y), bfhi(yw.y)}; }
                ss += (y[j].x * y[j].x + y[j].y * y[j].y) + (y[j].z * y[j].z + y[j].w * y[j].w); }
            const float rs = 1.0f / sqrtf(wave_sum(ss) * (1.f / D) + NORM_EPS);
#pragma unroll
            for (int j = 0; j < 4; ++j) { const v2u xw = xr[64 * j]; x[j] = (f32x4){bflo(xw.x), bfhi(xw.x), bflo(xw.y), bfhi(xw.y)} + gt[64 * j] * (y[j] * rs * gp[64 * j]); }
        }
        if (do_h) { v2u* xo = (v2u*)(X + (size_t)m * D) + lane;
#pragma unroll
            for (int j = 0; j < 4; ++j) { v2u w; w.x = pk2(x[j].x, x[j].y); w.y = pk2(x[j].z, x[j].w); xo[64 * j] = w; }
        } else { f32x4* xo = (f32x4*)(A.out + (size_t)m * D) + lane;
#pragma unroll
            for (int j = 0; j < 4; ++j) xo[64 * j] = x[j]; }
        if (do_h) {
            float ss = 0.f;
#pragma unroll
            for (int j = 0; j < 4; ++j) ss += (x[j].x * x[j].x + x[j].y * x[j].y) + (x[j].z * x[j].z + x[j].w * x[j].w);
            const float rs = 1.0f / sqrtf(wave_sum(ss) * (1.f / D) + NORM_EPS);
            const f32x4* sh = (const f32x4*)(mods + ((size_t)lh * NROWC + n) * 6144 + shift_i * D) + lane;
            const f32x4* sc = (const f32x4*)(mods + ((size_t)lh * NROWC + n) * 6144 + scale_i * D) + lane;
            const f32x4* gp = (const f32x4*)gpre + lane;
            v2u* ho = (v2u*)(HB + (size_t)m * D) + lane;
#pragma unroll
            for (int j = 0; j < 4; ++j) { const f32x4 h = x[j] * rs * gp[64 * j] * (sc[64 * j] + 1.0f) + sh[64 * j]; v2u w; w.x = pk2(h.x, h.y); w.y = pk2(h.z, h.w); ho[64 * j] = w; }
        }
    }
}

__device__ __forceinline__ float sigmoidf_(float x) { return __builtin_amdgcn_rcpf(1.0f + __expf(-x)); }
__device__ __forceinline__ float rwkv_prev(const Args& A, const bf16* PB, int e, int m, int col) {
    if (m < MP) return ((m & 2047) == 0) ? 0.f : bf2f(PB[(size_t)(m - 1) * BCOLS + col]);
    const int t = (m - MP) & 7, b = (m - MP) >> 3;
    return (t == 0) ? A.in[I_SSHIFT][((size_t)e * NSB + b) * BCOLS + col] : bf2f(PB[(size_t)(m - 1) * BCOLS + col]);
}
__device__ __forceinline__ bf16x8 pack_frag(const float (&x)[8]) { v4u w; w.x = pk2(x[0], x[1]); w.y = pk2(x[2], x[3]); w.z = pk2(x[4], x[5]); w.w = pk2(x[6], x[7]); return __builtin_bit_cast(bf16x8, w); }
__device__ __forceinline__ void rwkv_prep(const Args& A, Frame& F, int e) {
    const int tid = F.tid, lane = F.lane, wave = F.wave, il = lane & 15, g = lane >> 4;
    const bf16* PB = (const bf16*)(A.ws + WS_PB); bf16* RW = (bf16*)(A.ws + WS_RW); float* DEC = (float*)(A.ws + WS_DEC); bf16* G = (bf16*)(A.ws + WS_G); float* BON = (float*)(A.ws + WS_BON);
    LAS unsigned char* LW_hi = F.lds; LAS unsigned char* LW_lo = F.lds + 4096; LAS unsigned char* LA = F.lds + 8192; LAS unsigned char* LG = F.lds + 12288;
    const float* mu = A.in[I_MU] + (size_t)e * BCOLS;
    LAS float* CONSTL = (LAS float*)(F.lds + 20480);
    LAS unsigned char* PBL = F.lds + 36864 + wave * 6656;
    LAS unsigned char* OUTL = F.lds + 90112 + wave * 4096;
    for (int i = tid; i < 8 * 512; i += NWAVES * 64) { const int arr = i >> 9, c = i & 511;
        CONSTL[i] = (arr == 0) ? A.in[I_W0][e * BW + c] : (arr == 1) ? A.in[I_A0][e * BW + c] : (arr == 2) ? A.in[I_KK][e * BW + c] : (arr == 3) ? A.in[I_KA][e * BW + c]
                  : (arr == 4) ? A.in[I_RK][e * BW + c] : mu[(arr - 5) * 512 + c]; }
    bf16x8 bw_hi[4], ba[4], bg[4][2];
#pragma unroll
    for (int ct = 0; ct < 4; ++ct) { const int col = 64 * wave + 16 * ct + il; float x[8];
#pragma unroll
        for (int k = 0; k < 8; ++k) x[k] = A.in[I_RW2][((size_t)e * 32 + 8 * g + k) * BW + col];
        bw_hi[ct] = pack_frag(x);
#pragma unroll
        for (int k = 0; k < 8; ++k) x[k] = A.in[I_A2][((size_t)e * 32 + 8 * g + k) * BW + col];
        ba[ct] = pack_frag(x);
#pragma unroll
        for (int s2 = 0; s2 < 2; ++s2) {
#pragma unroll
            for (int k = 0; k < 8; ++k) x[k] = A.in[I_G2][((size_t)e * 64 + 32 * s2 + 8 * g + k) * BW + col];
            bg[ct][s2] = pack_frag(x); } }
#pragma unroll 1
    for (int pass = 0; pass < 2; ++pass) {
        const int m_first = (pass == 0) ? 64 * F.vcu : (MP + 16 * F.vcu), ntok = (pass == 0) ? 64 : 16;
        if (pass == 1 && F.vcu >= 16) break;
#pragma unroll 1
        for (int idx0 = tid; idx0 < ntok * 128; idx0 += 4 * NWAVES * 64) {
            float sa_pb[4], sa_pv[4], sa_sv[4];
#pragma unroll
            for (int u = 0; u < 4; ++u) { const int idx = idx0 + u * (NWAVES * 64), tk = idx >> 7, c = idx & 127, m = m_first + tk, col = 1536 + c;
                sa_pb[u] = bf2f(PB[(size_t)m * BCOLS + col]); sa_pv[u] = bf2f(PB[(size_t)(m > 0 ? m - 1 : 0) * BCOLS + col]);
                sa_sv[u] = (pass == 1) ? A.in[I_SSHIFT][((size_t)e * NSB + ((m - MP) >> 3)) * BCOLS + col] : 0.f; }
            __builtin_amdgcn_sched_barrier(0);
#pragma unroll
            for (int u = 0; u < 4; ++u) { const int idx = idx0 + u * (NWAVES * 64), tk = idx >> 7, c = idx & 127, m = m_first + tk, col = 1536 + c;
                float prev = sa_pv[u];
                if (pass == 0) { if ((m & 2047) == 0) prev = 0.f; } else { if (((m - MP) & 7) == 0) prev = sa_sv[u]; }
                const float xm = sa_pb[u] + mu[col] * (prev - sa_pb[u]);
                if (c < 32) { const float t2 = __expf(2.f * xm), o = 1.f - 2.f * __builtin_amdgcn_rcpf(t2 + 1.f); const unsigned hb = f2bf(o);
                    *(LAS unsigned short*)(LW_hi + tk * 64 + c * 2) = (unsigned short)hb; *(LAS unsigned short*)(LW_lo + tk * 64 + c * 2) = (unsigned short)f2bf(o - __builtin_bit_cast(float, hb << 16)); }
                else if (c < 64) *(LAS unsigned short*)(LA + tk * 64 + (c - 32) * 2) = (unsigned short)f2bf(xm);
                else *(LAS unsigned short*)(LG + tk * 128 + (c - 64) * 2) = (unsigned short)f2bf(sigmoidf_(xm)); }
        }
        __syncthreads();
#pragma unroll 1
        for (int tt = 0; tt < ntok / 16; ++tt) {
            const int tok = 16 * tt + il;
            const bf16x8 aw_hi = *(const LAS bf16x8*)(LW_hi + tok * 64 + g * 16), aw_lo = *(const LAS bf16x8*)(LW_lo + tok * 64 + g * 16), aa = *(const LAS bf16x8*)(LA + tok * 64 + g * 16);
            const bf16x8 ag0 = *(const LAS bf16x8*)(LG + tok * 128 + g * 16), ag1 = *(const LAS bf16x8*)(LG + tok * 128 + 64 + g * 16);
            f32x4 zw[4], za[4], gg[4];
#pragma unroll
            for (int ct = 0; ct < 4; ++ct) { const f32x4 z = {0.f, 0.f, 0.f, 0.f};
                const f32x4 w = __builtin_amdgcn_mfma_f32_16x16x32_bf16(aw_hi, bw_hi[ct], z, 0, 0, 0); zw[ct] = __builtin_amdgcn_mfma_f32_16x16x32_bf16(aw_lo, bw_hi[ct], w, 0, 0, 0);
                za[ct] = __builtin_amdgcn_mfma_f32_16x16x32_bf16(aa, ba[ct], z, 0, 0, 0);
                f32x4 gq = __builtin_amdgcn_mfma_f32_16x16x32_bf16(ag0, bg[ct][0], z, 0, 0, 0); gg[ct] = __builtin_amdgcn_mfma_f32_16x16x32_bf16(ag1, bg[ct][1], gq, 0, 0, 0); }
            const int mt0 = m_first + 16 * tt;
            for (int c = lane; c < 17 * 24; c += 64) { const int rowi = c / 24, rem = c % 24, arr = rem >> 3, ch = rem & 7; int mm = mt0 - 1 + rowi; mm = mm < 0 ? 0 : mm;
                *(LAS v4u*)(PBL + (rowi * 3 + arr) * 128 + ch * 16) = *(const v4u*)(PB + (size_t)mm * BCOLS + arr * 512 + 64 * wave + 8 * ch); }
            asm volatile("" ::: "memory");
#pragma unroll 1
            for (int rp = 0; rp < 4; ++rp) { const int tl = 4 * g + rp, m = mt0 + tl;
                const bool start = (pass == 0) ? ((m & 2047) == 0) : (((m - MP) & 7) == 0);
                float r_[4], kp_[4], v_[4], dec_[4], kk_[4], a_[4]; float ssq = 0.f;
#pragma unroll
                for (int ct = 0; ct < 4; ++ct) { const int cl = 16 * ct + il, col = 64 * wave + cl;
                    const LAS unsigned short* pc = (const LAS unsigned short*)(PBL + ((tl + 1) * 3) * 128) + cl; const LAS unsigned short* pp = (const LAS unsigned short*)(PBL + (tl * 3) * 128) + cl;
                    const float c_r = bf2f(pc[0]), c_k = bf2f(pc[64]), c_v = bf2f(pc[128]); float p_r = bf2f(pp[0]), p_k = bf2f(pp[64]), p_v = bf2f(pp[128]);
                    if (pass == 1) { const float* sq = A.in[I_SSHIFT] + ((size_t)e * NSB + ((m - MP) >> 3)) * BCOLS; const float s0 = sq[col], s1 = sq[512 + col], s2 = sq[1024 + col];
                        if (start) { p_r = s0; p_k = s1; p_v = s2; } }
                    else if (start) { p_r = 0.f; p_k = 0.f; p_v = 0.f; }
                    const float r = c_r + CONSTL[5 * 512 + col] * (p_r - c_r), k = c_k + CONSTL[6 * 512 + col] * (p_k - c_k), v = c_v + CONSTL[7 * 512 + col] * (p_v - c_v);
                    const float z = zw[ct][rp] + CONSTL[col], nz = -z, sp = fmaxf(nz, 0.f) + __logf(1.0f + __expf(-fabsf(nz)));
                    dec_[ct] = __expf(-__expf(-sp - 0.5f));
                    a_[ct] = sigmoidf_(za[ct][rp] + CONSTL[512 + col]);
                    const float kk = k * CONSTL[2 * 512 + col]; kk_[ct] = kk; ssq += kk * kk;
                    kp_[ct] = k * (1.f + (a_[ct] - 1.f) * CONSTL[3 * 512 + col]); r_[ct] = r; v_[ct] = v; }
                ssq = row16_sum(ssq); const float rn = __builtin_amdgcn_rsqf(ssq + 1e-12f);
                float bon = 0.f, br = 0.f, kr = 0.f;
                LAS unsigned char* orec = OUTL + g * 1024;
#pragma unroll
                for (int ct = 0; ct < 4; ++ct) { const int cl = 16 * ct + il, col = 64 * wave + cl; const float kkn = kk_[ct] * rn, bq = kkn * a_[ct];
                    bon += r_[ct] * kp_[ct] * CONSTL[4 * 512 + col]; br += bq * r_[ct]; kr += kp_[ct] * r_[ct];
                    LAS unsigned short* o16 = (LAS unsigned short*)orec + cl;
                    o16[0] = (unsigned short)f2bf(-kkn); o16[64] = (unsigned short)f2bf(bq); o16[128] = (unsigned short)f2bf(kp_[ct]); o16[192] = (unsigned short)f2bf(dec_[ct] * r_[ct]); o16[256] = (unsigned short)f2bf(v_[ct]);
                    ((LAS float*)(orec + 640))[cl] = dec_[ct]; ((LAS unsigned short*)(orec + 896))[cl] = (unsigned short)f2bf(gg[ct][rp]); }
                bon = row16_sum(bon); br = row16_sum(br); kr = row16_sum(kr);
                if (il == 0) *(f32x4*)(BON + ((size_t)m * 8 + wave) * 4) = (f32x4){br, kr, bon, 0.f};
                asm volatile("s_waitcnt lgkmcnt(0)" ::: "memory");
#pragma unroll
                for (int sl = 0; sl < 4; ++sl) { const size_t mo = (size_t)(mt0 + 4 * sl + rp); const v4u x = *(const LAS v4u*)(OUTL + sl * 1024 + lane * 16);
                    unsigned char* dst = (lane < 40) ? ((unsigned char*)(RW + (mo * 8 + wave) * 320) + lane * 16)
                                       : (lane < 56) ? ((unsigned char*)(DEC + (mo * 8 + wave) * 64) + (lane - 40) * 16)
                                                     : ((unsigned char*)(G + mo * BW + 64 * wave) + (lane - 56) * 16);
                    *(v4u*)dst = x; }
                asm volatile("" ::: "memory");
            }
        }
        __syncthreads();
    }
    { const int gt = F.vcu * (NWAVES * 64) + tid, NGT = F.G * NWAVES * 64;
      for (int i = gt; i < NROWC * BCOLS; i += NGT) { const int n = i / BCOLS, c = i % BCOLS;
          if (n < NB) A.out[O_SHP + ((size_t)e * NB + n) * BCOLS + c] = bf2f(PB[((size_t)n * SEQ + SEQ - 1) * BCOLS + c]);
          else A.out[O_SHS + ((size_t)e * NSB + (n - NB)) * BCOLS + c] = bf2f(PB[((size_t)MP + (size_t)(n - NB) * DSEQ + DSEQ - 1) * BCOLS + c]); } }
}

__device__ __forceinline__ void gmlp_prompt_unit(const Args& A, Frame& F, int e, int chunk, int half) {
    const int lane = F.lane, wave = F.wave;
    const bf16* VG = (const bf16*)(A.ws + WS_VG); const bf16* U = (const bf16*)(A.ws + WS_U); bf16* MIX = (bf16*)(A.ws + WS_MIX);
    const bf16* TR = (const bf16*)(A.ws + WS_TRIL) + (size_t)e * 4 * 128 * 128;
    constexpr int VP = 272;
    const int m0 = chunk * 128;
    const float* lng = A.in[I_LNG] + (size_t)e * AW + 256 * half; const float* lnb = A.in[I_LNB] + (size_t)e * AW + 256 * half;
    float gsc[4], gbi[4];
#pragma unroll
    for (int q = 0; q < 4; ++q) { gsc[q] = lng[lane + 64 * q]; gbi[q] = lnb[lane + 64 * q]; }
#pragma unroll 1
    for (int rb = 0; rb < 16; rb += 8) {
        v4u raw[8]; unsigned short hv[8][4];
#pragma unroll
        for (int u = 0; u < 8; ++u) { const bf16* vr = VG + (size_t)(m0 + wave * 16 + rb + u) * AW; raw[u] = *(const v4u*)(vr + 8 * lane);
#pragma unroll
            for (int q = 0; q < 4; ++q) hv[u][q] = vr[256 * half + lane + 64 * q]; }
#pragma unroll
        for (int u = 0; u < 8; ++u) { const int jrow = wave * 16 + rb + u;
            float s = 0.f, s2 = 0.f;
#pragma unroll
            for (int q = 0; q < 4; ++q) { const float a = bflo(raw[u][q]), b = bfhi(raw[u][q]); s += a + b; s2 += a * a + b * b; }
            s = wave_sum(s); s2 = wave_sum(s2);
            const float mean = s * (1.f / AW), var = fmaxf(s2 * (1.f / AW) - mean * mean, 0.f), rstd = 1.0f / sqrtf(var + LN_EPS);
#pragma unroll
            for (int q = 0; q < 4; ++q) { const int c = lane + 64 * q; const float x = bf2f(hv[u][q]);
                *(LAS unsigned short*)(F.lds + c * VP + jrow * 2) = (unsigned short)f2bf((x - mean) * rstd * gsc[q] + gbi[q]); }
        }
    }
    __syncthreads();
    const int i0 = 16 * wave, il = lane & 15, g4 = lane >> 4, nks = (i0 + 15) / 32 + 1;
#pragma unroll
    for (int gi = 0; gi < 2; ++gi) { const int g = 2 * half + gi;
        f32x4 acc[8];
#pragma unroll
        for (int ct = 0; ct < 8; ++ct) acc[ct] = (f32x4){0.f, 0.f, 0.f, 0.f};
        bf16x8 Bfr[4];
#pragma unroll
        for (int s = 0; s < 4; ++s) Bfr[s] = *(const bf16x8*)(TR + ((size_t)g * 128 + i0 + il) * 128 + 32 * s + 8 * g4);
#pragma unroll
        for (int s = 0; s < 4; ++s) { if (s < nks) { const bf16x8 Bf = Bfr[s];
#pragma unroll
            for (int ct = 0; ct < 8; ++ct) { const bf16x8 Af = *(const LAS bf16x8*)(F.lds + (128 * gi + 16 * ct + il) * VP + (32 * s + 8 * g4) * 2);
                acc[ct] = __builtin_amdgcn_mfma_f32_16x16x32_bf16(Af, Bf, acc[ct], 0, 0, 0); }
        } }
        const int tok = i0 + il; const float bsv = A.in[I_BS][((size_t)e * 4 + g) * 128 + tok];
        const size_t rowoff = (size_t)(m0 + tok) * AW + 128 * g + 4 * g4;
#pragma unroll
        for (int ct = 0; ct < 8; ++ct) { const v2u uu = *(const v2u*)(U + rowoff + 16 * ct);
            const float o0 = bflo(uu.x) * (acc[ct][0] + bsv), o1 = bfhi(uu.x) * (acc[ct][1] + bsv), o2 = bflo(uu.y) * (acc[ct][2] + bsv), o3 = bfhi(uu.y) * (acc[ct][3] + bsv);
            v2u w; w.x = pk2(o0, o1); w.y = pk2(o2, o3);
            *(v2u*)(MIX + (size_t)(m0 + tok) * D + 128 * g + 16 * ct + 4 * g4) = w; }
    }
    __syncthreads();
}
__device__ __forceinline__ void gmlp_sample_unit(const Args& A, Frame& F, int e, int b) {
    const int tid = F.tid, lane = F.lane, wave = F.wave, c = tid, g = c >> 7;
    const bf16* VG = (const bf16*)(A.ws + WS_VG); const bf16* U = (const bf16*)(A.ws + WS_U); bf16* MIX = (bf16*)(A.ws + WS_MIX);
    LAS float* red = (LAS float*)F.lds;
    const int m0 = MP + b * DSEQ;
    float v[8];
#pragma unroll
    for (int t = 0; t < 8; ++t) v[t] = bf2f(VG[(size_t)(m0 + t) * AW + c]);
#pragma unroll
    for (int t = 0; t < 8; ++t) { const float s = wave_sum(v[t]), s2 = wave_sum(v[t] * v[t]); if (lane == 0) { red[wave * 16 + t] = s; red[wave * 16 + 8 + t] = s2; } }
    __syncthreads();
    const float lg = A.in[I_LNG][e * AW + c], lb = A.in[I_LNB][e * AW + c];
#pragma unroll
    for (int t = 0; t < 8; ++t) { float s = 0.f, s2 = 0.f;
#pragma unroll
        for (int w = 0; w < 8; ++w) { s += red[w * 16 + t]; s2 += red[w * 16 + 8 + t]; }
        const float mean = s * (1.f / AW), var = fmaxf(s2 * (1.f / AW) - mean * mean, 0.f), rstd = 1.0f / sqrtf(var + LN_EPS);
        v[t] = (v[t] - mean) * rstd * lg + lb;
        A.out[O_GV + (((size_t)e * NSB + b) * DSEQ + t) * AW + c] = v[t]; }
    const float* ws = A.in[I_WS] + ((size_t)e * 4 + g) * 128 * 128; const float* bs = A.in[I_BS] + ((size_t)e * 4 + g) * 128;
#pragma unroll
    for (int i = 0; i < 8; ++i) { float z = bs[i];
#pragma unroll
        for (int jj = 0; jj <= i; ++jj) z += ws[i * 128 + jj] * v[jj];
        ((bf16*)MIX)[(size_t)(m0 + i) * D + c] = (bf16)f2bf(bf2f(U[(size_t)(m0 + i) * AW + c]) * z); }
    __syncthreads();
}

struct ScanOps { f32x4 aq01, aq23, w4, b4, k4, rr; };
__device__ __forceinline__ ScanOps scan_load(const LAS float* rec  , int ks, const LAS float* rrec  ) {
    ScanOps o; o.aq01 = *(const LAS f32x4*)(rec + 8 * ks); o.aq23 = *(const LAS f32x4*)(rec + 8 * ks + 4); o.w4 = *(const LAS f32x4*)(rec + 128 + 4 * ks);
    o.b4 = *(const LAS f32x4*)(rec + 192 + 4 * ks); o.k4 = *(const LAS f32x4*)(rec + 256 + 4 * ks); o.rr = *(const LAS f32x4*)rrec; return o;
}
__device__ __forceinline__ float scan_step(f32x4& S, const ScanOps& p) {
    f32x2 acc = (f32x2){p.aq01[0], p.aq01[1]} * S[0];
    acc = (f32x2){p.aq01[2], p.aq01[3]} * S[1] + acc;
    acc = (f32x2){p.aq23[0], p.aq23[1]} * S[2] + acc;
    acc = (f32x2){p.aq23[2], p.aq23[3]} * S[3] + acc;
    const f32x4 u = S * p.w4 + p.k4 * p.rr[0];
    float p1 = acc.x, p2 = acc.y;
    p1 += dpp<XOR1>(p1); p2 += dpp<XOR1>(p2); p1 += dpp<XOR2>(p1); p2 += dpp<XOR2>(p2);
    p1 += dpp<ROR4>(p1); p2 += dpp<ROR4>(p2); p1 += dpp<XOR8>(p1); p2 += dpp<XOR8>(p2);
    S = p.b4 * p1 + u;
    return __builtin_fmaf(p1, p.rr[1], __builtin_fmaf(p.rr[0], p.rr[2], p2));
}
__device__ __forceinline__ void scan_prompt(const Args& A, Frame& F, int e) {
    const int tid = F.tid, lane = F.lane, wave = F.wave;
    const int b = F.vcu >> 5, h = (F.vcu >> 2) & 7, q = F.vcu & 3;
    const bf16* RW = (const bf16*)(A.ws + WS_RW); const float* DEC = (const float*)(A.ws + WS_DEC); const float* SCL = (const float*)(A.ws + WS_BON); float* OSC = (float*)(A.ws + WS_OSC);
    constexpr int BLK = 32, BUFB = BLK * 1536;
    LAS unsigned char* buf0 = F.lds; LAS float* obuf = (LAS float*)(F.lds + 2 * BUFB);
    LAS float* dump = obuf + 1024;
    const size_t mbase = (size_t)b * SEQ;
    const bool loader = wave >= 4; const int ltid = tid - 256;
    const int ks = lane & 15, rl = 4 * (wave & 3) + (lane >> 4), row = 16 * q + rl;
    f32x4 S = {0.f, 0.f, 0.f, 0.f};
    v4u la, lq, lbk[2]; f32x4 ld[2]; unsigned short lv[2]; f32x2 lsc[2];
    const int ast = ltid >> 3, ac8 = ltid & 7;
    int bsrc[2], bdst[2], dsrc[2], ddst[2];
#pragma unroll
    for (int i = 0; i < 2; ++i) { const int idx = ltid + 256 * i, st = idx >> 4, r2 = idx & 15, arr = 1 + (r2 >> 3), c8 = r2 & 7;
        bsrc[i] = (st * 8) * 320 + arr * 64 + 8 * c8; bdst[i] = (st * 384 + 128 + 64 * arr + 8 * c8) * 4;
        const int c4 = idx & 15; dsrc[i] = (st * 8) * 64 + 4 * c4; ddst[i] = (st * 384 + 128 + 4 * c4) * 4; }
    const bf16* RWh = RW + (mbase * 8 + h) * 320; const float* DEh = DEC + (mbase * 8 + h) * 64; const float* SCh = SCL + (mbase * 8 + h) * 4;
#define SCAN_LOAD(blk_) do { const bf16* rb_ = RWh + (size_t)(blk_) * (BLK * 8 * 320); \
        la = *(const v4u*)(rb_ + (ast * 8) * 320 + 8 * ac8); lq = *(const v4u*)(rb_ + (ast * 8) * 320 + 192 + 8 * ac8); \
        _Pragma("unroll") for (int i = 0; i < 2; ++i) { const int idx_ = ltid + 256 * i, st_ = idx_ >> 4, r_ = idx_ & 15; lbk[i] = *(const v4u*)(rb_ + bsrc[i]); \
            ld[i] = *(const f32x4*)(DEh + (size_t)(blk_) * (BLK * 8 * 64) + dsrc[i]); \
            lv[i] = rb_[(size_t)st_ * (8 * 320) + 256 + 16 * q + r_]; lsc[i] = *(const f32x2*)(SCh + ((size_t)(blk_) * BLK + st_) * 32); } } while (0)
#define SCAN_PUT(bufi_) do { LAS unsigned char* bb_ = buf0 + (size_t)(bufi_) * BUFB; LAS unsigned char* aq_ = bb_ + (ast * 384 + 16 * ac8) * 4; \
        *(LAS f32x4*)(aq_) = (f32x4){bflo(la.x), bflo(lq.x), bfhi(la.x), bfhi(lq.x)}; *(LAS f32x4*)(aq_ + 16) = (f32x4){bflo(la.y), bflo(lq.y), bfhi(la.y), bfhi(lq.y)}; \
        *(LAS f32x4*)(aq_ + 32) = (f32x4){bflo(la.z), bflo(lq.z), bfhi(la.z), bfhi(lq.z)}; *(LAS f32x4*)(aq_ + 48) = (f32x4){bflo(la.w), bflo(lq.w), bfhi(la.w), bfhi(lq.w)}; \
        _Pragma("unroll") for (int i = 0; i < 2; ++i) { const int idx_ = ltid + 256 * i, st_ = idx_ >> 4, r_ = idx_ & 15; LAS unsigned char* d_ = bb_ + bdst[i]; \
            *(LAS f32x4*)d_ = (f32x4){bflo(lbk[i].x), bfhi(lbk[i].x), bflo(lbk[i].y), bfhi(lbk[i].y)}; *(LAS f32x4*)(d_ + 16) = (f32x4){bflo(lbk[i].z), bfhi(lbk[i].z), bflo(lbk[i].w), bfhi(lbk[i].w)}; \
            *(LAS f32x4*)(bb_ + ddst[i]) = ld[i]; \
            *(LAS f32x4*)(bb_ + (st_ * 384 + 320 + 4 * r_) * 4) = (f32x4){bf2f(lv[i]), lsc[i][0], lsc[i][1], 0.f}; } } while (0)
#define SCAN_BAR() do { asm volatile("s_waitcnt lgkmcnt(0)" ::: "memory"); __builtin_amdgcn_s_barrier(); asm volatile("" ::: "memory"); } while (0)
    if (loader) { SCAN_LOAD(0); SCAN_PUT(0); SCAN_LOAD(1); }
    SCAN_BAR();
    for (int blk = 0; blk < SEQ / BLK; ++blk) {
        const int cur = blk & 1;
        if (loader) {
            if (blk + 1 < SEQ / BLK) SCAN_PUT(cur ^ 1);
            if (blk + 2 < SEQ / BLK) SCAN_LOAD(blk + 2);
            if (blk > 0) {
#pragma unroll
                for (int i = 0; i < 2; ++i) { const int idx = ltid + 256 * i, st = idx >> 4, r16 = idx & 15;
                    OSC[(mbase + (size_t)(blk - 1) * BLK + st) * BW + h * 64 + 16 * q + r16] = obuf[(cur ^ 1) * 512 + idx]; } }
        } else {
            const LAS float* rec0 = (const LAS float*)(buf0 + (size_t)cur * BUFB);
            LAS float* od = (ks == 0) ? (obuf + cur * 512 + rl) : (dump + lane);
            const int ostep = (ks == 0) ? 16 : 0;
            const unsigned vq = (unsigned)(uintptr_t)(rec0 + 8 * ks), vv = (unsigned)(uintptr_t)(rec0 + 4 * ks), ra = (unsigned)(uintptr_t)(rec0 + 320 + 4 * rl);
            ScanOps ring[3];
#define SCAN_ASMLOAD(dst_, st_) asm volatile("ds_read_b128 %0, %6 offset:%9\n\tds_read_b128 %1, %6 offset:%10\n\tds_read_b128 %2, %7 offset:%11\n\tds_read_b128 %3, %7 offset:%12\n\tds_read_b128 %4, %7 offset:%13\n\tds_read_b128 %5, %8 offset:%9" \
                : "=&v"((dst_).aq01), "=&v"((dst_).aq23), "=&v"((dst_).w4), "=&v"((dst_).b4), "=&v"((dst_).k4), "=&v"((dst_).rr) : "v"(vq), "v"(vv), "v"(ra), \
                  "n"((st_) * 1536), "n"((st_) * 1536 + 16), "n"((st_) * 1536 + 512), "n"((st_) * 1536 + 768), "n"((st_) * 1536 + 1024) : "memory")
            SCAN_ASMLOAD(ring[0], 0); SCAN_ASMLOAD(ring[1], 1);
#pragma unroll
            for (int st = 0; st < BLK; ++st) {
#define SCAN_WAIT(N_, r_) asm volatile("s_waitcnt lgkmcnt(" #N_ ")" : "+v"((r_).aq01), "+v"((r_).aq23), "+v"((r_).w4), "+v"((r_).b4), "+v"((r_).k4), "+v"((r_).rr) :: "memory")
                if (st + 2 < BLK) { SCAN_ASMLOAD(ring[(st + 2) % 3], (st + 2 < BLK ? st + 2 : BLK - 1)); SCAN_WAIT(12, ring[st % 3]); }
                else if (st + 1 < BLK) SCAN_WAIT(6, ring[st % 3]);
                else SCAN_WAIT(0, ring[st % 3]);
#undef SCAN_WAIT
                const float o = scan_step(S, ring[st % 3]); od[st * ostep] = o; }
#undef SCAN_ASMLOAD
        }
        SCAN_BAR();
    }
#undef SCAN_LOAD
#undef SCAN_PUT
#undef SCAN_BAR
    if (loader) {
#pragma unroll
        for (int i = 0; i < 2; ++i) { const int idx = ltid + 256 * i, st = idx >> 4, r16 = idx & 15;
            OSC[(mbase + (size_t)(SEQ - BLK) + st) * BW + h * 64 + 16 * q + r16] = obuf[((SEQ / BLK - 1) & 1) * 512 + idx]; }
    } else {
        *(f32x4*)(A.out + O_WKVP + ((((size_t)e * NB + b) * 8 + h) * 64 + row) * 64 + 4 * ks) = S;
    }
    __syncthreads();
}
__device__ __forceinline__ void scan_sample(const Args& A, Frame& F, int e, int sb, int h) {
    const int tid = F.tid, lane = F.lane, wave = F.wave;
    const bf16* RW = (const bf16*)(A.ws + WS_RW); const float* DEC = (const float*)(A.ws + WS_DEC); const float* SCL = (const float*)(A.ws + WS_BON); float* OSC = (float*)(A.ws + WS_OSC);
    constexpr int REC = 320 + 256;
    LAS float* ob = (LAS float*)F.lds;
    const size_t m0 = (size_t)MP + (size_t)sb * DSEQ;
    for (int idx = tid; idx < 8 * 256; idx += NWAVES * 64) { const int st = idx >> 8, r2 = idx & 255, arr = r2 >> 6, c = r2 & 63;
        const float val = bf2f(RW[((m0 + st) * 8 + h) * 320 + r2]);
        ob[st * REC + ((arr == 0) ? 2 * c : (arr == 3) ? 2 * c + 1 : 128 + 64 * arr + c)] = val; }
    { const int st = tid >> 6, c = tid & 63; ob[st * REC + 128 + c] = DEC[((m0 + st) * 8 + h) * 64 + c];
      const f32x2 bk = *(const f32x2*)(SCL + ((m0 + st) * 8 + h) * 4);
      *(LAS f32x4*)(ob + st * REC + 320 + 4 * c) = (f32x4){bf2f(RW[((m0 + st) * 8 + h) * 320 + 256 + c]), bk[0], bk[1], 0.f}; }
    __syncthreads();
    const int ks = lane & 15;
#pragma unroll
    for (int p = 0; p < 2; ++p) { const int row = 32 * p + 4 * wave + (lane >> 4);
        const size_t sidx = ((((size_t)e * NSB + sb) * 8 + h) * 64 + row) * 64 + 4 * ks;
        f32x4 S = *(const f32x4*)(A.in[I_SWKV] + sidx);
#pragma unroll
        for (int st = 0; st < 8; ++st) { const ScanOps c = scan_load(ob + st * REC, ks, ob + st * REC + 320 + 4 * row); const float o = scan_step(S, c); if (ks == 0) OSC[(m0 + st) * BW + h * 64 + row] = o; }
        *(f32x4*)(A.out + O_WKVS + sidx) = S; }
    __syncthreads();
}
__device__ __forceinline__ void rwkv_finalize(const Args& A, Frame& F, int e) {
    const int j = F.tid, lane = F.lane, wave = F.wave;
    const bf16* RW = (const bf16*)(A.ws + WS_RW); const float* OSC = (const float*)(A.ws + WS_OSC); const bf16* G = (const bf16*)(A.ws + WS_G); const float* BON = (const float*)(A.ws + WS_BON);
    bf16* MIX = (bf16*)(A.ws + WS_MIX);
    const float lg = A.in[I_LNXG][e * BW + j], lb = A.in[I_LNXB][e * BW + j];
#pragma unroll 1
    for (int pass = 0; pass < 2; ++pass) {
        if (pass == 1 && (F.vcu < 16 || F.vcu >= 32)) break;
        const int m_lo = (pass == 0) ? 64 * F.vcu : (MP + 16 * (F.vcu - 16)), m_hi = m_lo + ((pass == 0) ? 64 : 16);
        float o_[8], g_[8], bn_[8]; unsigned short v_[8], gq_[8];
#define FIN_LOAD(mb_) do { const float* op = OSC + (size_t)(mb_) * BW + j; const bf16* vp = RW + ((size_t)(mb_) * 8 + wave) * 320 + 256 + lane; const bf16* gp = G + (size_t)(mb_) * BW + j; \
            const float* bp = BON + ((size_t)(mb_) * 8 + wave) * 4 + 2; _Pragma("unroll") for (int u = 0; u < 8; ++u) { o_[u] = op[u * BW]; v_[u] = vp[u * 2560]; gq_[u] = gp[u * BW]; bn_[u] = bp[u * 32]; } } while (0)
        FIN_LOAD(m_lo);
#pragma unroll 1
        for (int mb = m_lo; mb < m_hi; mb += 8) {
            float co[8], cv[8], cg[8], cb[8];
#pragma unroll
            for (int u = 0; u < 8; ++u) { co[u] = o_[u]; cv[u] = bf2f(v_[u]); cg[u] = bf2f(gq_[u]); cb[u] = bn_[u]; }
            if (mb + 8 < m_hi) FIN_LOAD(mb + 8);
            __builtin_amdgcn_sched_barrier(0);
#pragma unroll
            for (int u = 0; u < 8; ++u) {
                const float mean = wave_sum(co[u]) * (1.f / 64.f), dd = co[u] - mean, var = wave_sum(dd * dd) * (1.f / 64.f);
                const float on = dd * __builtin_amdgcn_rsqf(var + GN_EPS) * lg + lb;
                MIX[(size_t)(mb + u) * D + 512 + j] = (bf16)f2bf((on + cb[u] * cv[u]) * cg[u]); }
        }
#undef FIN_LOAD
    }
}

__device__ __forceinline__ const char* uniform_ptr(const char* p) { const unsigned long long v = (unsigned long long)p;
    const unsigned lo = __builtin_amdgcn_readfirstlane((unsigned)v), hi = __builtin_amdgcn_readfirstlane((unsigned)(v >> 32)); return (const char*)(((unsigned long long)hi << 32) | lo); }
template <int DIL> __device__ __forceinline__ void attn_subblock(const bf16* __restrict__ Q, const bf16* __restrict__ K, const bf16* __restrict__ VT, int b, int h, int cls, int mq0,
                                                              int lane, f32x4 (&oacc)[2][4], float (&lse2)[2]) {
    constexpr int SUBLEN = SEQ / DIL;
    const int il = lane & 15, g = lane >> 4;
    const int kbase = mq0 - 128;
    const int g0 = (kbase < 0) ? ((-kbase) >> 5) : 0;
    const char* qb = (const char*)(Q + ((size_t)b * SEQ + (size_t)mq0 * DIL + cls) * D + h * 64);
    const char* kb = (const char*)K + (((long)((b * 16 + h) * DIL + cls)) * SUBLEN + kbase) * 128;
    const char* vb = (const char*)VT + ((((long)((b * 16 + h) * DIL + cls)) * (SUBLEN / 16) + (kbase >> 4)) * 64) * 32;
    qb = uniform_ptr(qb); kb = uniform_ptr(kb); vb = uniform_ptr(vb);
    unsigned qoff = (unsigned)(il * DIL * D + 8 * g) * 2u, koff = (unsigned)((8 * (il >> 2) + (il & 3)) * 128 + 16 * g), voff = (unsigned)((g >> 1) * 2048 + il * 32 + (g & 1) * 16);
    asm volatile("" : "+v"(qoff), "+v"(koff), "+v"(voff));
    bf16x8 qf[2][2], kf[5][2][2]; v4u vf[4][5];
#pragma unroll
    for (int tq = 0; tq < 2; ++tq) { qf[tq][0] = *(const bf16x8*)(qb + (qoff + (unsigned)(tq * 16 * DIL * D * 2))); qf[tq][1] = *(const bf16x8*)(qb + (qoff + (unsigned)(tq * 16 * DIL * D * 2) + 64u)); }
#pragma unroll
    for (int G = 0; G < 5; ++G) {
        if (G == 4 || G >= g0) {
#pragma unroll
            for (int hf = 0; hf < 2; ++hf) { const unsigned c = (unsigned)((32 * G + 4 * hf) * 128);
                kf[G][hf][0] = *(const bf16x8*)(kb + (koff + c)); kf[G][hf][1] = *(const bf16x8*)(kb + (koff + c + 64u)); }
        } else {
#pragma unroll
            for (int hf = 0; hf < 2; ++hf) { kf[G][hf][0] = (bf16x8){0, 0, 0, 0, 0, 0, 0, 0}; kf[G][hf][1] = (bf16x8){0, 0, 0, 0, 0, 0, 0, 0}; }
        }
    }
#define ATT_VLOAD(dt0, dt1) do { _Pragma("unroll") for (int G = 0; G < 5; ++G) { if (G == 4 || G >= g0) { _Pragma("unroll") for (int dt = (dt0); dt < (dt1); ++dt) \
        vf[dt][G] = *(const v4u*)(vb + (voff + (unsigned)(2 * G * 2048 + 16 * dt * 32))); } else { _Pragma("unroll") for (int dt = (dt0); dt < (dt1); ++dt) vf[dt][G] = (v4u){0u, 0u, 0u, 0u}; } } } while (0)
    ATT_VLOAD(0, 2);
    __builtin_amdgcn_sched_barrier(0);
    bf16x8 pf[2][5]; float rsum[2];
#pragma unroll
    for (int tq = 0; tq < 2; ++tq) {
        f32x4 sc[5][2];
#pragma unroll
        for (int G = 0; G < 5; ++G)
#pragma unroll
            for (int hf = 0; hf < 2; ++hf) { f32x4 a = {0.f, 0.f, 0.f, 0.f};
                a = __builtin_amdgcn_mfma_f32_16x16x32_bf16(kf[G][hf][0], qf[tq][0], a, 0, 0, 0);
                a = __builtin_amdgcn_mfma_f32_16x16x32_bf16(kf[G][hf][1], qf[tq][1], a, 0, 0, 0);
                sc[G][hf] = a; }
        __builtin_amdgcn_sched_barrier(0);
        if (tq == 1) { ATT_VLOAD(2, 4); __builtin_amdgcn_sched_barrier(0); }
        int t = 8 * g - il - 16 * tq; asm volatile("" : "+v"(t));
#pragma unroll
        for (int hf = 0; hf < 2; ++hf)
#pragma unroll
            for (int r = 0; r < 4; ++r) { if (!(t + (4 * hf + r) >= 0)) sc[0][hf][r] = -INFINITY; if (!(t + (128 + 4 * hf + r) <= 128)) sc[4][hf][r] = -INFINITY; }
        if (g0 > 0) {
#pragma unroll
            for (int G = 0; G < 4; ++G) { const bool dead = G < g0;
#pragma unroll
                for (int hf = 0; hf < 2; ++hf)
#pragma unroll
                    for (int r = 0; r < 4; ++r) if (dead) sc[G][hf][r] = -INFINITY; }
        }
        float mx = -INFINITY;
#pragma unroll
        for (int G = 0; G < 5; ++G)
#pragma unroll
            for (int hf = 0; hf < 2; ++hf)
#pragma unroll
                for (int r = 0; r < 4; ++r) mx = fmaxf(mx, sc[G][hf][r]);
        mx = xrow16_max(mx);
        float sum = 0.f;
#pragma unroll
        for (int G = 0; G < 5; ++G) { float p[8];
#pragma unroll
            for (int hf = 0; hf < 2; ++hf)
#pragma unroll
                for (int r = 0; r < 4; ++r) { const float e = __builtin_amdgcn_exp2f(sc[G][hf][r] - mx); p[4 * hf + r] = e; sum += e; }
            v4u w; w.x = pk2(p[0], p[1]); w.y = pk2(p[2], p[3]); w.z = pk2(p[4], p[5]); w.w = pk2(p[6], p[7]); pf[tq][G] = __builtin_bit_cast(bf16x8, w); }
        sum = xrow16_sum(sum);
        rsum[tq] = __builtin_amdgcn_rcpf(sum);
        lse2[tq] = mx + __builtin_amdgcn_logf(sum);
        __builtin_amdgcn_sched_barrier(0);
    }
#undef ATT_VLOAD
#pragma unroll
    for (int tq = 0; tq < 2; ++tq)
#pragma unroll
        for (int dt = 0; dt < 4; ++dt) { f32x4 o = {0.f, 0.f, 0.f, 0.f};
#pragma unroll
            for (int G = 0; G < 5; ++G) o = __builtin_amdgcn_mfma_f32_16x16x32_bf16(__builtin_bit_cast(bf16x8, vf[dt][G]), pf[tq][G], o, 0, 0, 0);
            oacc[tq][dt] = o * rsum[tq]; }
}
template <int STAGE  > __device__ __forceinline__ void attn_combine(LAS float* oimg, LAS float* mimg, int pl, int g, const f32x4 (&o)[4], float lse2, bf16* mixrow) {
    LAS float* orow = oimg + pl * 64; const int sw = (pl ^ (pl >> 2) ^ (pl >> 4)) & 15;
    if (STAGE == 0) {
#pragma unroll
        for (int dt = 0; dt < 4; ++dt) *(LAS f32x4*)(orow + 4 * ((g + 4 * dt) ^ sw)) = o[dt];
        if (g == 0) { mimg[2 * pl] = lse2; mimg[2 * pl + 1] = 1.f; }
    } else {
        const float m0 = mimg[2 * pl], den0 = mimg[2 * pl + 1];
        const float mn = fmaxf(m0, lse2), fa = __builtin_amdgcn_exp2f(m0 - mn), fb = __builtin_amdgcn_exp2f(lse2 - mn), den = den0 * fa + fb;
        if (STAGE == 1) {
#pragma unroll
            for (int dt = 0; dt < 4; ++dt) { LAS f32x4* p = (LAS f32x4*)(orow + 4 * ((g + 4 * dt) ^ sw)); const f32x4 a = *p; *p = a * fa + o[dt] * fb; }
            if (g == 0) { mimg[2 * pl] = mn; mimg[2 * pl + 1] = den; }
        } else {
            const float inv = 1.0f / den;
#pragma unroll
            for (int dt = 0; dt < 4; ++dt) { const f32x4 a = *(LAS f32x4*)(orow + 4 * ((g + 4 * dt) ^ sw)); const f32x4 r = (a * fa + o[dt] * fb) * inv;
                v2u w; w.x = pk2(r[0], r[1]); w.y = pk2(r[2], r[3]); *(v2u*)(mixrow + 16 * dt + 4 * g) = w; }
        }
    }
}
__device__ __forceinline__ void attn_prompt_unit(const Args& A, Frame& F, int unit) {
    const int lane = F.lane, wave = F.wave, il = lane & 15, g = lane >> 4;
    const int bh = unit >> 2, tile = unit & 3, b = bh >> 4, h = bh & 15, P0 = 512 * tile;
    const bf16* Q = (const bf16*)(A.ws + WS_Q); const bf16* K1 = (const bf16*)(A.ws + WS_K); const bf16* K4 = (const bf16*)(A.ws + WS_K4); const bf16* K16 = (const bf16*)(A.ws + WS_K16);
    const bf16* VT1 = (const bf16*)(A.ws + WS_VT1); const bf16* VT4 = (const bf16*)(A.ws + WS_VT4); const bf16* VT16 = (const bf16*)(A.ws + WS_VT16);
    bf16* MIX = (bf16*)(A.ws + WS_MIX);
    LAS float* oimg = (LAS float*)F.lds; LAS float* mimg = (LAS float*)(F.lds + LDSCTL_OFF + 1024);
    f32x4 o[2][4]; float lse2[2];
#pragma unroll 1
    for (int s = 0; s < 2; ++s) { const int cls = 2 * wave + s, mq0 = P0 / 16;
        attn_subblock<16>(Q, K16, VT16, b, h, cls, mq0, lane, o, lse2);
#pragma unroll
        for (int tq = 0; tq < 2; ++tq) attn_combine<0>(oimg, mimg, 16 * (16 * tq + il) + cls, g, o[tq], lse2[tq], nullptr); }
    __syncthreads();
#pragma unroll 1
    for (int s = 0; s < 2; ++s) { const int sb = 2 * wave + s, cls = sb & 3, mq0 = P0 / 4 + 32 * (sb >> 2);
        attn_subblock<4>(Q, K4, VT4, b, h, cls, mq0, lane, o, lse2);
#pragma unroll
        for (int tq = 0; tq < 2; ++tq) attn_combine<1>(oimg, mimg, 128 * (sb >> 2) + 4 * (16 * tq + il) + cls, g, o[tq], lse2[tq], nullptr); }
    __syncthreads();
#pragma unroll 1
    for (int s = 0; s < 2; ++s) { const int sb = 2 * wave + s, mq0 = P0 + 32 * sb;
        attn_subblock<1>(Q, K1, VT1, b, h, 0, mq0, lane, o, lse2);
#pragma unroll
        for (int tq = 0; tq < 2; ++tq) { const int pl = 32 * sb + 16 * tq + il;
            attn_combine<2>(oimg, mimg, pl, g, o[tq], lse2[tq], MIX + ((size_t)b * SEQ + P0 + pl) * D + h * 64); } }
    __syncthreads();
}
__device__ __forceinline__ void vt_build_unit(const Args& A, Frame& F, int unit) {
    const int tid = F.tid;
    const int bh = unit >> 3, tile = unit & 7, b = bh >> 4, h = bh & 15, P0 = 256 * tile;
    const bf16* VB = (const bf16*)(A.ws + WS_VB);
    bf16* VT1 = (bf16*)(A.ws + WS_VT1); bf16* VT4 = (bf16*)(A.ws + WS_VT4); bf16* VT16 = (bf16*)(A.ws + WS_VT16);
    constexpr int LP = 264;
    LAS unsigned short* LT = (LAS unsigned short*)F.lds;
    { const int r = tid >> 1, hf = tid & 1; const bf16* src = VB + ((size_t)b * SEQ + P0 + r) * D + h * 64 + 32 * hf;
      v4u x[4];
#pragma unroll
      for (int i = 0; i < 4; ++i) x[i] = *(const v4u*)(src + 8 * i);
#pragma unroll
      for (int i = 0; i < 4; ++i)
#pragma unroll
          for (int q = 0; q < 4; ++q) { const int dd = 32 * hf + 8 * i + 2 * q; LT[dd * LP + r] = (unsigned short)(x[i][q] & 0xffffu); LT[(dd + 1) * LP + r] = (unsigned short)(x[i][q] >> 16); } }
    __syncthreads();
#pragma unroll
    for (int c = 0; c < 4; ++c) { const int idx = tid + 512 * c, blk = idx >> 7, dd = (idx >> 1) & 63, hf = idx & 1;
        { const v4u w = *(const LAS v4u*)(LT + dd * LP + 16 * blk + 8 * hf);
          *(v4u*)(VT1 + ((((size_t)bh * 128 + P0 / 16 + blk) * 64 + dd) * 16 + 8 * hf)) = w; }
        { const int cls = blk >> 2, mo = 16 * (blk & 3) + 8 * hf; unsigned short e[8];
#pragma unroll
          for (int j = 0; j < 8; ++j) e[j] = LT[dd * LP + 4 * (mo + j) + cls];
          v4u w; w.x = e[0] | ((unsigned)e[1] << 16); w.y = e[2] | ((unsigned)e[3] << 16); w.z = e[4] | ((unsigned)e[5] << 16); w.w = e[6] | ((unsigned)e[7] << 16);
          *(v4u*)(VT4 + (((((size_t)bh * 4 + cls) * 32 + P0 / 64 + (blk & 3)) * 64 + dd) * 16 + 8 * hf)) = w; }
        { const int cls = blk, mo = 8 * hf; unsigned short e[8];
#pragma unroll
          for (int j = 0; j < 8; ++j) e[j] = LT[dd * LP + 16 * (mo + j) + cls];
          v4u w; w.x = e[0] | ((unsigned)e[1] << 16); w.y = e[2] | ((unsigned)e[3] << 16); w.z = e[4] | ((unsigned)e[5] << 16); w.w = e[6] | ((unsigned)e[7] << 16);
          *(v4u*)(VT16 + (((((size_t)bh * 16 + cls) * 8 + P0 / 256) * 64 + dd) * 16 + 8 * hf)) = w; }
    }
    __syncthreads();
}
template <bool LDSB> __device__ __forceinline__ void smp_branch(const float* ck, const float* cv, const float* kn, const float* vn, const LAS float* lk, const LAS float* lv,
                                                              int dil, int t, int grp, int kl, const f32x4& q4, f32x4& oa_out, float& lse_out) {
    float sreg[33]; float mx = -INFINITY;
    const int idx0 = 2048 + t - grp * dil;
#pragma unroll
    for (int c0 = 0; c0 < 34; c0 += 17) { f32x4 kk[17];
#pragma unroll
        for (int u = 0; u < 17; ++u) { if (c0 + u < 33) { const int idx = idx0 - 4 * (c0 + u) * dil; const int idc = idx < 0 ? 0 : idx;
            if (LDSB) { kk[u] = *(const LAS f32x4*)(lk + (32 - (c0 + u)) * 256); }
            else { const float* kp = (c0 + u < 2 && idc >= 2048) ? (kn + (size_t)(idc - 2048) * D) : (ck + (size_t)idc * D); kk[u] = *(const f32x4*)kp; } } }
        __builtin_amdgcn_sched_barrier(0);
#pragma unroll
        for (int u = 0; u < 17; ++u) { if (c0 + u < 33) { const int j = 4 * (c0 + u) + grp;
            float s = __builtin_fmaf(q4[3], kk[u][3], __builtin_fmaf(q4[2], kk[u][2], __builtin_fmaf(q4[1], kk[u][1], q4[0] * kk[u][0])));
            s = row16_sum(s); s = (j <= 128) ? s : -INFINITY; sreg[c0 + u] = s; mx = fmaxf(mx, s); } }
    }
    mx = xrow16_max(mx);
    float sum = 0.f; f32x4 oa = {0.f, 0.f, 0.f, 0.f};
#pragma unroll
    for (int c0 = 0; c0 < 34; c0 += 17) { f32x4 vv[17];
#pragma unroll
        for (int u = 0; u < 17; ++u) { if (c0 + u < 33) { const int idx = idx0 - 4 * (c0 + u) * dil; const int idc = idx < 0 ? 0 : idx;
            if (LDSB) { vv[u] = *(const LAS f32x4*)(lv + (32 - (c0 + u)) * 256); }
            else { const float* vp = (c0 + u < 2 && idc >= 2048) ? (vn + (size_t)(idc - 2048) * D) : (cv + (size_t)idc * D); vv[u] = *(const f32x4*)vp; } } }
        __builtin_amdgcn_sched_barrier(0);
#pragma unroll
        for (int u = 0; u < 17; ++u) { if (c0 + u < 33) { const float p = __builtin_amdgcn_exp2f(sreg[c0 + u] - mx); sum += p; oa += vv[u] * p; } }
    }
    sum = xrow16_sum(sum);
#pragma unroll
    for (int c = 0; c < 4; ++c) oa[c] = xrow16_sum(oa[c]);
    oa_out = oa * __builtin_amdgcn_rcpf(sum); lse_out = mx + __builtin_amdgcn_logf(sum);
}
__device__ __forceinline__ void attn_sample_unit(const Args& A, Frame& F, int o_idx, int su) {
    const int lane = F.lane, t = F.wave, kl = lane & 15, grp = lane >> 4;
    const int sb = su >> 4, h = su & 15;
    const bf16* Q = (const bf16*)(A.ws + WS_Q); bf16* MIX = (bf16*)(A.ws + WS_MIX);
    const float* ck0 = A.in[I_CK] + (((size_t)o_idx * NSB + sb) * 2048) * D + h * 64;
    const float* cv0 = A.in[I_CV] + (((size_t)o_idx * NSB + sb) * 2048) * D + h * 64;
    const float* kn0 = A.out + O_KS + ((size_t)o_idx * MS + (size_t)sb * DSEQ) * D + h * 64;
    const float* vn0 = A.out + O_VS + ((size_t)o_idx * MS + (size_t)sb * DSEQ) * D + h * 64;
    LAS float* lk = (LAS float*)F.lds; LAS float* lv = (LAS float*)(F.lds + 36864);
    if (F.tid < 64) { *(LAS f32x4*)(lk + 4 * F.tid) = (f32x4){0.f, 0.f, 0.f, 0.f}; *(LAS f32x4*)(lv + 4 * F.tid) = (f32x4){0.f, 0.f, 0.f, 0.f}; }
#pragma unroll
    for (int it = 0; it < 5; ++it) { const int idx = F.tid + 512 * it, li = idx >> 4, c4 = idx & 15;
        if (li < 136) { const float* ks = (li < 128) ? (ck0 + (size_t)(1920 + li) * D) : (kn0 + (size_t)(li - 128) * D); const float* vs = (li < 128) ? (cv0 + (size_t)(1920 + li) * D) : (vn0 + (size_t)(li - 128) * D);
            *(LAS f32x4*)(lk + (li + 4) * 64 + 4 * c4) = *(const f32x4*)(ks + 4 * c4); *(LAS f32x4*)(lv + (li + 4) * 64 + 4 * c4) = *(const f32x4*)(vs + 4 * c4); } }
    const float* ck = ck0 + 4 * kl; const float* cv = cv0 + 4 * kl; const float* kn = kn0 + 4 * kl; const float* vn = vn0 + 4 * kl;
    const size_t mrow = (size_t)MP + (size_t)sb * DSEQ + t;
    f32x4 q4; { const v2u qw = *(const v2u*)(Q + mrow * D + h * 64 + 4 * kl); q4 = (f32x4){bflo(qw.x), bfhi(qw.x), bflo(qw.y), bfhi(qw.y)}; }
    __syncthreads();
    f32x4 accO; float mrun, den = 1.f;
    smp_branch<true>(ck, cv, kn, vn, lk + (t - grp + 4) * 64 + 4 * kl, lv + (t - grp + 4) * 64 + 4 * kl, 1, t, grp, kl, q4, accO, mrun);
#pragma unroll 1
    for (int br = 1; br < 3; ++br) { const int dil = (br == 1) ? 4 : 16;
        f32x4 oa; float lse2;
        smp_branch<false>(ck, cv, kn, vn, lk, lv, dil, t, grp, kl, q4, oa, lse2);
        const float mn = fmaxf(mrun, lse2), fa = __builtin_amdgcn_exp2f(mrun - mn), fb = __builtin_amdgcn_exp2f(lse2 - mn); accO = accO * fa + oa * fb; den = den * fa + fb; mrun = mn;
    }
    accO = accO * (1.0f / den);
    if (grp == 0) { v2u w; w.x = pk2(accO[0], accO[1]); w.y = pk2(accO[2], accO[3]); *(v2u*)(MIX + mrow * D + h * 64 + 4 * kl) = w; }
    __syncthreads();
}


template <int KS, class Epi> __device__ __forceinline__ void small_gemm(Frame& F, const bf16* __restrict__ Am  , const bf16* __restrict__ Bt  , int N, int K, const Epi& E, int rank, int nrank) {
    constexpr int TPW = 8 / KS;
    const int tid = F.tid, lane = F.lane, wave = F.wave, il = lane & 15, g = lane >> 4;
    const int ntn = N / 32, ntiles = 8 * ntn, kw = K / KS, nks = kw / 32;
    LAS float* P = (LAS float*)F.lds;
    for (int base = rank * TPW; base < ntiles; base += nrank * TPW) {
        const int slot = wave / KS, kpart = wave % KS, tile = base + slot;
        if (tile < ntiles) {
            const int tm = tile & 7, tn = tile >> 3;
            const bf16* ap = Am + (size_t)(32 * tm + il) * K + (size_t)kpart * kw + 8 * g;
            const bf16* bp = Bt + (size_t)(32 * tn + il) * K + (size_t)kpart * kw + 8 * g;
            f32x4 acc[2][2];
#pragma unroll
            for (int i = 0; i < 2; ++i)
#pragma unroll
                for (int j = 0; j < 2; ++j) acc[i][j] = (f32x4){0.f, 0.f, 0.f, 0.f};
#pragma unroll 8
            for (int s2 = 0; s2 < nks; ++s2) {
                const bf16x8 a0 = *(const bf16x8*)(ap + 32 * s2), a1 = *(const bf16x8*)(ap + (size_t)16 * K + 32 * s2);
                const bf16x8 b0 = *(const bf16x8*)(bp + 32 * s2), b1 = *(const bf16x8*)(bp + (size_t)16 * K + 32 * s2);
                acc[0][0] = __builtin_amdgcn_mfma_f32_16x16x32_bf16(a0, b0, acc[0][0], 0, 0, 0); acc[0][1] = __builtin_amdgcn_mfma_f32_16x16x32_bf16(a0, b1, acc[0][1], 0, 0, 0);
                acc[1][0] = __builtin_amdgcn_mfma_f32_16x16x32_bf16(a1, b0, acc[1][0], 0, 0, 0); acc[1][1] = __builtin_amdgcn_mfma_f32_16x16x32_bf16(a1, b1, acc[1][1], 0, 0, 0);
            }
            LAS float* pw = P + (slot * KS + kpart) * 1056;
#pragma unroll
            for (int i = 0; i < 2; ++i)
#pragma unroll
                for (int j = 0; j < 2; ++j)
#pragma unroll
                    for (int r = 0; r < 4; ++r) pw[(16 * i + 4 * g + r) * 33 + 16 * j + il] = acc[i][j][r];
        }
        __syncthreads();
        float sum[2 * TPW];
#pragma unroll
        for (int e2 = 0; e2 < 2 * TPW; ++e2) { const int idx = tid + 512 * e2, sl = idx >> 10, w = idx & 1023, r = w >> 5, c = w & 31; float v = 0.f;
#pragma unroll
            for (int kp = 0; kp < KS; ++kp) v += P[(sl * KS + kp) * 1056 + r * 33 + c];
            sum[e2] = v; }
        if (Epi::NEEDS_TILE) { __syncthreads();
#pragma unroll
            for (int e2 = 0; e2 < 2 * TPW; ++e2) { const int idx = tid + 512 * e2, sl = idx >> 10, w = idx & 1023, r = w >> 5, c = w & 31; P[(sl * KS) * 1056 + r * 33 + c] = sum[e2]; }
            __syncthreads(); }
#pragma unroll
        for (int e2 = 0; e2 < 2 * TPW; ++e2) { const int idx = tid + 512 * e2, sl = idx >> 10, w = idx & 1023, r = w >> 5, c = w & 31, tile = base + sl;
            if (tile < ntiles) E(32 * (tile & 7) + r, 32 * (tile >> 3) + c, sum[e2], P + (sl * KS) * 1056 + r * 33, c); }
        __syncthreads();
    }
}
template <class Epi, int KQ = 1> __device__ __forceinline__ void small_gemm64(Frame& F, const bf16* __restrict__ Am  , const bf16* __restrict__ Bt  , int N, int K, const Epi& E, int rank, int nrank, float* part = nullptr) {
    const int tid = F.tid, lane = F.lane, wave = F.wave, il = lane & 15, g = lane >> 4;
    const int ntiles = 4 * (N / 64), kw = K / (8 * KQ), nks = kw / 32;
    LAS float* P = (LAS float*)F.lds;
    for (int item = rank; item < ntiles * KQ; item += nrank) {
        const int tile = item / KQ, kq = item % KQ, tm = tile & 3, tn = tile >> 2;
        const bf16* ap = Am + (size_t)(64 * tm + il) * K + (size_t)(kq * 8 + wave) * kw + 8 * g;
        const bf16* bp = Bt + (size_t)(64 * tn + il) * K + (size_t)(kq * 8 + wave) * kw + 8 * g;
        f32x4 acc[4][4];
#pragma unroll
        for (int i = 0; i < 4; ++i)
#pragma unroll
            for (int j = 0; j < 4; ++j) acc[i][j] = (f32x4){0.f, 0.f, 0.f, 0.f};
        bf16x8 fa[2][1][4], fb[2][1][4];
#define SG_LOAD(buf_, s0_) do { _Pragma("unroll") for (int u = 0; u < 1; ++u) _Pragma("unroll") for (int i = 0; i < 4; ++i) { \
            fa[buf_][u][i] = *(const bf16x8*)(ap + (size_t)(16 * i) * K + 32 * ((s0_) + u)); fb[buf_][u][i] = *(const bf16x8*)(bp + (size_t)(16 * i) * K + 32 * ((s0_) + u)); } } while (0)
#define SG_MMA(buf_) do { _Pragma("unroll") for (int u = 0; u < 1; ++u) _Pragma("unroll") for (int i = 0; i < 4; ++i) _Pragma("unroll") for (int j = 0; j < 4; ++j) \
            acc[i][j] = __builtin_amdgcn_mfma_f32_16x16x32_bf16(fa[buf_][u][i], fb[buf_][u][j], acc[i][j], 0, 0, 0); } while (0)
        SG_LOAD(0, 0);
#pragma unroll 1
        for (int s0 = 0; s0 < nks; s0 += 2) {
            SG_LOAD(1, s0 + 1);
            __builtin_amdgcn_sched_barrier(0);
            SG_MMA(0);
            __builtin_amdgcn_sched_barrier(0);
            if (s0 + 2 < nks) SG_LOAD(0, s0 + 2);
            __builtin_amdgcn_sched_barrier(0);
            SG_MMA(1);
            __builtin_amdgcn_sched_barrier(0);
        }
#undef SG_LOAD
#undef SG_MMA
        LAS float* pw = P + wave * 4096;
#pragma unroll
        for (int i = 0; i < 4; ++i)
#pragma unroll
            for (int j = 0; j < 4; ++j)
#pragma unroll
                for (int r = 0; r < 4; ++r) pw[(16 * i + 4 * g + r) * 64 + 16 * j + il] = acc[i][j][r];
        __syncthreads();
        float sum[8];
#pragma unroll
        for (int e2 = 0; e2 < 8; ++e2) { const int idx = tid + 512 * e2; float v = 0.f;
#pragma unroll
            for (int kp = 0; kp < 8; ++kp) v += P[kp * 4096 + idx];
            sum[e2] = v; }
        if (KQ > 1) {
#pragma unroll
            for (int e2 = 0; e2 < 8; ++e2) { const int idx = tid + 512 * e2, r = idx >> 6, c = idx & 63;
                part[((size_t)kq * 256 + 64 * tm + r) * N + 64 * tn + c] = sum[e2]; }
        } else {
            if (Epi::NEEDS_TILE) { __syncthreads();
#pragma unroll
                for (int e2 = 0; e2 < 8; ++e2) P[tid + 512 * e2] = sum[e2];
                __syncthreads(); }
#pragma unroll
            for (int e2 = 0; e2 < 8; ++e2) { const int idx = tid + 512 * e2, r = idx >> 6, c = idx & 63;
                E(64 * tm + r, 64 * tn + c, sum[e2], P + r * 64, c); }
        }
        __syncthreads();
    }
}
__device__ __forceinline__ float gelu1(float v) { const pg8::f32x2 r = pg8::gelu_pk((pg8::f32x2){v, 0.f}); return r.x; }
struct SEpiEvenIn { static constexpr bool NEEDS_TILE = false; bf16* U; bf16* VG; bf16* PB;
    __device__ __forceinline__ void operator()(int row, int col, float v, const LAS float*, int) const { const size_t m = (size_t)MP + row;
        if (col < 512) U[m * 512 + col] = (bf16)f2bf(gelu1(v)); else if (col < 1024) VG[m * 512 + (col - 512)] = (bf16)f2bf(gelu1(v)); else PB[m * BCOLS + (col - 1024)] = (bf16)f2bf(v); } };
struct SEpiF32 { static constexpr bool NEEDS_TILE = false; bf16* Y; int ldc;
    __device__ __forceinline__ void operator()(int row, int col, float v, const LAS float*, int) const { Y[((size_t)MP + row) * ldc + col] = (bf16)f2bf(v); } };
struct SEpiRelu2 { static constexpr bool NEEDS_TILE = false; bf16* O; int ldc;
    __device__ __forceinline__ void operator()(int row, int col, float v, const LAS float*, int) const { const float a = v > 0.f ? v : 0.f; O[((size_t)MP + row) * ldc + col] = (bf16)f2bf(a * a); } };
struct SEpiQKV { static constexpr bool NEEDS_TILE = true; bf16* Q; float* ks; float* vs; const float* rope;
    __device__ __forceinline__ void operator()(int row, int col, float v, const LAS float* trow, int c) const {
        const int sec = col >> 10, cc = col & 1023, d = cc & 63;
        if (sec < 2 && d < 16) { const float other = trow[c ^ 8]; const float* cs = rope + ((size_t)(2048 + (row & 7)) * 8 + (d & 7)) * 2; v = v * cs[0] + ((d < 8) ? -other : other) * cs[1]; }
        if (sec == 0) Q[((size_t)MP + row) * D + cc] = (bf16)f2bf(v * (0.125f * 1.4426950408889634f));
        else if (sec == 1) ks[(size_t)row * D + cc] = v; else vs[(size_t)row * D + cc] = v; } };

#ifndef REP_GEMM
#define REP_GEMM 1
#endif
#ifndef REP_PREP
#define REP_PREP 1
#endif
#ifndef REP_GMLP
#define REP_GMLP 1
#endif
#ifndef REP_ATTP
#define REP_ATTP 1
#endif
#ifndef REP_ATTS
#define REP_ATTS 1
#endif
#ifndef REP_SCAN
#define REP_SCAN 1
#endif
#ifndef REP_FIN
#define REP_FIN 1
#endif
#ifndef REP_P0
#define REP_P0 1
#endif
#ifndef REP_N0
#define REP_N0 1
#endif
constexpr int N_PHASES = 2 + 10 * DEPTH;
#define RUN(k) (lo <= (k) && (k) < hi)
#define SEAM(k, nk) do { if (RUN(k) && RUN(nk)) xcd_barrier(bar); } while (0)
template <int L> __device__ __forceinline__ void layer_phases(const Args& A, Frame& F, const XcdBarrier& bar, const int lo, const int hi) {

        constexpr int l = L, pb = 2 + 10 * L, eo = L >> 1; constexpr bool even = (L & 1) == 0;
        const pg8::bf16_t* HB = (const pg8::bf16_t*)(A.ws + WS_HB);
        if (RUN(pb)) {
            if constexpr (even) {
                pg8::Gemm g{HB, (const pg8::bf16_t*)(A.ws + WS_WINT) + (size_t)eo * EVEN_IN_PAD * D, MP, EVEN_IN_PAD, D}; pg8::StaticOrder S; S.init(MP, EVEN_IN_PAD, F.G, (int)blockIdx.x);
                pg8::EpiEvenIn E{(pg8::bf16_t*)(A.ws + WS_U), (pg8::bf16_t*)(A.ws + WS_VG), (pg8::bf16_t*)(A.ws + WS_PB)};
                _Pragma("unroll 1") for (int rep_ = 0; rep_ < REP_GEMM; ++rep_) pg8::gemm_phase<pg8::EpiEvenIn, pg8::StaticOrder, PG8_ALIGN, PG8_SP2>(F.lds, g, S, E);
                { SEpiEvenIn SE{(bf16*)(A.ws + WS_U), (bf16*)(A.ws + WS_VG), (bf16*)(A.ws + WS_PB)};
                  const bool light = (F.G == 256); const int rk = light ? (int)blockIdx.x - 192 : F.vcu, nrk = light ? 64 : F.G;
                  if (rk >= 0) small_gemm64(F, (const bf16*)(A.ws + WS_HB) + (size_t)MP * D, (const bf16*)(A.ws + WS_WINT) + (size_t)eo * EVEN_IN_PAD * D, EVEN_IN, D, SE, rk, nrk); }
            } else {
                pg8::Gemm g{HB, (const pg8::bf16_t*)(A.ws + WS_WQKVT) + (size_t)eo * 3 * D * D, MP, 3 * D, D}; pg8::QkvOrder S; S.init(MP, D, F.G, (int)blockIdx.x);
                pg8::EpiQKV E{(pg8::bf16_t*)(A.ws + WS_Q), (pg8::bf16_t*)(A.ws + WS_K), (pg8::bf16_t*)(A.ws + WS_K4), (pg8::bf16_t*)(A.ws + WS_K16), (pg8::bf16_t*)(A.ws + WS_VB),
                              A.out + O_KP + (size_t)eo * MP * D, A.out + O_VP + (size_t)eo * MP * D, A.out + O_KS + (size_t)eo * MS * D, A.out + O_VS + (size_t)eo * MS * D, (const float*)(A.ws + WS_ROPE)};
                _Pragma("unroll 1") for (int rep_ = 0; rep_ < REP_GEMM; ++rep_) pg8::gemm_phase<pg8::EpiQKV, pg8::QkvOrder, PG8_ALIGN, PG8_SP2>(F.lds, g, S, E);
                { SEpiQKV SE{(bf16*)(A.ws + WS_Q), A.out + O_KS + (size_t)eo * MS * D, A.out + O_VS + (size_t)eo * MS * D, (const float*)(A.ws + WS_ROPE)};
                  small_gemm64(F, (const bf16*)(A.ws + WS_HB) + (size_t)MP * D, (const bf16*)(A.ws + WS_WQKVT) + (size_t)eo * 3 * D * D, 3 * D, D, SE, F.vcu, F.G); }
                asm volatile("s_waitcnt vmcnt(0)" ::: "memory"); __syncthreads();
#pragma unroll 1
                for (int i = 0; i < 3; ++i) { pg8::Unit uu; if (!S.next(i, uu)) break; if (uu.pn < 8) continue;
#pragma unroll 1
                    for (int hh = 0; hh < 4; ++hh) vt_build_unit(A, F, (((uu.pm >> 3) * 16 + 4 * (uu.pn - 8) + hh) << 3) | (uu.pm & 7)); }
            }
        }
        if constexpr (even) SEAM(pb, pb + 1); else SEAM(pb, pb + 2);
        if (even && RUN(pb + 1)) {
            if constexpr (even) {
                const bool gfirst = (F.vcu & 4) != 0;
                if (gfirst) { gmlp_prompt_unit(A, F, eo, F.vcu >> 1, F.vcu & 1); rwkv_prep(A, F, eo); }
                else { rwkv_prep(A, F, eo); gmlp_prompt_unit(A, F, eo, F.vcu >> 1, F.vcu & 1); }
                if (F.vcu >= F.G - NSB) gmlp_sample_unit(A, F, eo, F.vcu - (F.G - NSB));
            }
        }
        if constexpr (even) {
            SEAM(pb + 1, pb + 2);
            if (RUN(pb + 2)) {
#ifndef NO_SCAN
 _Pragma("unroll 1") for (int rep_ = 0; rep_ < REP_SCAN; ++rep_) scan_prompt(A, F, eo);
 scan_sample(A, F, eo, F.vcu >> 3, F.vcu & 7);
#endif
 }
            SEAM(pb + 2, pb + 3);
            if (RUN(pb + 3)) {
#ifndef NO_FIN
 _Pragma("unroll 1") for (int rep_ = 0; rep_ < REP_FIN; ++rep_) rwkv_finalize(A, F, eo);
#endif
 }
            SEAM(pb + 3, pb + 4);
        } else {
            if (RUN(pb + 2)) {
                if (F.vcu & 8) {
#pragma unroll 1
                    for (int i = 0; i < 2; ++i) attn_sample_unit(A, F, eo, F.vcu + 256 * i);
#pragma unroll 1
                    for (int i = 0; i < 2; ++i) attn_prompt_unit(A, F, F.vcu + 256 * i);
                } else {
#pragma unroll 1
                    for (int i = 0; i < 2; ++i) attn_prompt_unit(A, F, F.vcu + 256 * i);
#pragma unroll 1
                    for (int i = 0; i < 2; ++i) attn_sample_unit(A, F, eo, F.vcu + 256 * i);
                }
            }
            SEAM(pb + 2, pb + 4);
        }
        if (RUN(pb + 4)) {
            const pg8::bf16_t* W = even ? ((const pg8::bf16_t*)(A.ws + WS_WOUTT) + (size_t)eo * D * D) : ((const pg8::bf16_t*)(A.ws + WS_WOT) + (size_t)eo * D * D);
            pg8::Gemm g{(const pg8::bf16_t*)(A.ws + WS_MIX), W, MP, D, D}; pg8::StaticOrder S; S.init(MP, D, F.G, (int)blockIdx.x);
            pg8::EpiY16 E{(pg8::bf16_t*)(A.ws + WS_Y), D};
            _Pragma("unroll 1") for (int rep_ = 0; rep_ < REP_GEMM; ++rep_) pg8::gemm_phase<pg8::EpiY16, pg8::StaticOrder, PG8_ALIGN, PG8_SP2>(F.lds, g, S, E);
            { SEpiF32 SE{(bf16*)(A.ws + WS_Y), D}; small_gemm<8>(F, (const bf16*)(A.ws + WS_MIX) + (size_t)MP * D, (const bf16*)W, D, D, SE, F.vcu, F.G); }
        }
        SEAM(pb + 4, pb + 5);
        if (RUN(pb + 5)) { norm_phase<1>(A, F, l); } SEAM(pb + 5, pb + 6);
        if (RUN(pb + 6)) {
            pg8::Gemm g{HB, (const pg8::bf16_t*)(A.ws + WS_W1T) + (size_t)l * D * DFF, MP, DFF, D}; pg8::StaticOrder S; S.init(MP, DFF, F.G, (int)blockIdx.x);
            pg8::EpiRelu2 E{(pg8::bf16_t*)(A.ws + WS_FF), DFF};
            _Pragma("unroll 1") for (int rep_ = 0; rep_ < REP_GEMM; ++rep_) pg8::gemm_phase<pg8::EpiRelu2, pg8::StaticOrder, PG8_ALIGN, PG8_SP2>(F.lds, g, S, E);
            { SEpiRelu2 SE{(bf16*)(A.ws + WS_FF), DFF}; small_gemm64(F, (const bf16*)(A.ws + WS_HB) + (size_t)MP * D, (const bf16*)(A.ws + WS_W1T) + (size_t)l * D * DFF, DFF, D, SE, F.vcu, F.G); }
        }
        SEAM(pb + 6, pb + 7);
        if (RUN(pb + 7)) {
            pg8::Gemm g{(const pg8::bf16_t*)(A.ws + WS_FF), (const pg8::bf16_t*)(A.ws + WS_W2T) + (size_t)l * D * DFF, MP, D, DFF}; pg8::StaticOrder S; S.init(MP, D, F.G, (int)blockIdx.x);
            pg8::EpiY16 E{(pg8::bf16_t*)(A.ws + WS_Y), D};
            _Pragma("unroll 1") for (int rep_ = 0; rep_ < REP_GEMM; ++rep_) pg8::gemm_phase<pg8::EpiY16, pg8::StaticOrder, PG8_ALIGN, PG8_SP2>(F.lds, g, S, E);
            { SEpiF32 SE{(bf16*)(A.ws + WS_Y), D}; small_gemm64<SEpiF32, 4>(F, (const bf16*)(A.ws + WS_FF) + (size_t)MP * DFF, (const bf16*)(A.ws + WS_W2T) + (size_t)l * D * DFF, D, DFF, SE, F.vcu, F.G, (float*)(A.ws + WS_OSC)); }
        }
        SEAM(pb + 7, pb + 8);
        if (RUN(pb + 8)) { norm_phase<2>(A, F, l); }
        if (l + 1 < DEPTH) SEAM(pb + 8, pb + 10);

}
#undef RUN
#undef SEAM

__global__ void __launch_bounds__(NWAVES * 64, 2) fwd_kernel(Args A) {
    extern __shared__ __attribute__((aligned(16))) unsigned char lds_raw[];
    Frame F;
    F.lds = (LAS unsigned char*)lds_raw;
    F.MISC = (volatile LAS unsigned*)(F.lds + MISC_OFF);
    F.tid = threadIdx.x; F.lane = F.tid & 63; F.wave = __builtin_amdgcn_readfirstlane(F.tid >> 6);
    F.G = gridDim.x; { const int bx = blockIdx.x; F.vcu = (F.G % 8 == 0) ? (bx % 8) * (F.G / 8) + bx / 8 : bx; }
    F.ctl = (gu32*)(A.ws + WS_CTL);
    for (int u = F.tid; u < (LDS_BYTES - LDSCTL_OFF) / 4; u += NWAVES * 64) ((LAS unsigned*)(F.lds + LDSCTL_OFF))[u] = 0u;
    __syncthreads();
    const int lo = A.ph_lo, hi = A.ph_hi;
    XcdBarrier bar; bar.bar = (unsigned*)(F.ctl + CW_BAR); bar.x = 0; bar.st = nullptr;
    if (hi - lo > 1) bar = xcd_barrier_post((unsigned*)(F.ctl + CW_BAR), F.MISC + 8);
#define RUN(k) (lo <= (k) && (k) < hi)
#define SEAM(k, nk) do { if (RUN(k) && RUN(nk)) xcd_barrier(bar); } while (0)

    if (RUN(0)) {
#ifndef NO_P0
 _Pragma("unroll 1") for (int rep_ = 0; rep_ < REP_P0; ++rep_) { p0_prologue(A, F); __syncthreads(); }
#endif
 } SEAM(0, 1);
    if (RUN(1)) {
#ifndef NO_N
 _Pragma("unroll 1") for (int rep_ = 0; rep_ < REP_N0; ++rep_) norm_phase<0>(A, F, 0);
#endif
 } SEAM(1, 2);

    layer_phases<0>(A, F, bar, lo, hi); layer_phases<1>(A, F, bar, lo, hi); layer_phases<2>(A, F, bar, lo, hi); layer_phases<3>(A, F, bar, lo, hi);
#undef RUN
#undef SEAM
}

extern "C" void kernel_launch(void* const* d_in, const int* in_sizes, int n_in, void* d_out, int out_size, void* d_ws, size_t ws_size, hipStream_t stream) {
    static int grid = 0;
    if (grid == 0) {
        if (n_in != N_IN || (size_t)out_size != O_END || ws_size < WS_END) { fprintf(stderr, "kernel_launch: expected %d inputs, %zu outputs, >= %zu bytes of workspace; got %d, %d, %zu; nothing launched\n", (int)N_IN, (size_t)O_END, (size_t)WS_END, n_in, out_size, ws_size); grid = -1; return; }
        int dev = 0, cus = 0, per_cu = 0;
        if (hipGetDevice(&dev) != hipSuccess || hipDeviceGetAttribute(&cus, hipDeviceAttributeMultiprocessorCount, dev) != hipSuccess) { fprintf(stderr, "kernel_launch: device query failed\n"); grid = -1; return; }
        if (hipFuncSetAttribute((const void*)fwd_kernel, hipFuncAttributeMaxDynamicSharedMemorySize, LDS_BYTES) != hipSuccess) { fprintf(stderr, "kernel_launch: hipFuncSetAttribute failed\n"); grid = -1; return; }
        if (hipOccupancyMaxActiveBlocksPerMultiprocessor(&per_cu, (const void*)fwd_kernel, NWAVES * 64, LDS_BYTES) != hipSuccess || per_cu < 1)
            fprintf(stderr, "kernel_launch: note: occupancy query reports %d workgroups per CU\n", per_cu);
        (void)hipGetLastError();
        grid = cus;
        if (grid != 256) fprintf(stderr, "kernel_launch: %d CUs; this kernel is laid out for 256\n", grid);
    }
    if (grid < 0) return;
    if (hipMemsetAsync((char*)d_ws + WS_CTL, 0, CTL_ZERO_BYTES, stream) != hipSuccess) { fprintf(stderr, "kernel_launch: memset failed\n"); return; }
    Args a{};
    for (int i = 0; i < N_IN; ++i) a.in[i] = (const float*)d_in[i];
    a.out = (float*)d_out; a.ws = (unsigned char*)d_ws;
#if MK_PER_PHASE
    for (int k = 0; k < N_PHASES; ++k) {
        int cls = k;
        if (k >= 2) { const int l = (k - 2) / 10, j = (k - 2) % 10; if (j == 9) continue; if ((l & 1) && (j == 1 || j == 3)) continue;
            cls = (j == 0) ? ((l & 1) ? 3 : 2) : (j == 1) ? ((l & 1) ? 11 : 4) : (j == 2) ? ((l & 1) ? 5 : 6) : (j == 3) ? 7 : (j == 4) ? 8 : (j == 6) ? 9 : (j == 7) ? 10 : 31; }
        a.ph_lo = k; a.ph_hi = k + 1;
        const int nrep = ((PROBE_DUP_MASK >> cls) & 1) ? 2 : 1;
        for (int r = 0; r < nrep; ++r) hipLaunchKernelGGL(fwd_kernel, dim3(grid), dim3(NWAVES * 64), LDS_BYTES, stream, a);
    }
#else
    a.ph_lo = 0; a.ph_hi = N_PHASES;
    hipLaunchKernelGGL(fwd_kernel, dim3(grid), dim3(NWAVES * 64), LDS_BYTES, stream, a);
#endif
    const hipError_t le = hipPeekAtLastError();
    if (le != hipSuccess) fprintf(stderr, "kernel_launch: launch failed: %s\n", hipGetErrorName(le));
}
```

```cpp
#include <hip/hip_runtime.h>
#include <cstdio>
#include <cstdint>

namespace pg8 {
#define PG8_LAS __attribute__((address_space(3)))
typedef unsigned short bf16_t;
typedef short bf16x8 __attribute__((ext_vector_type(8)));
typedef float f32x4 __attribute__((ext_vector_type(4)));
typedef unsigned u32x4 __attribute__((ext_vector_type(4)));
constexpr int BM = 256, BK = 64, HALF = 128, HTB = HALF * BK * 2  , STAGE_BYTES = 8 * HTB, NXCD = 8, WGM = 8;

__host__ __device__ __forceinline__ int lds_byte(int r, int c) { const int st = (r >> 4) * 2 + (c >> 5), rr = r & 15, cc = c & 31, ob = rr * 64 + cc * 2; return st * 1024 + (ob ^ (((ob >> 9) & 1) << 5)); }
__host__ __device__ __forceinline__ void stage_rc(int b, int& R, int& C) { const int st = b / 1024, sb = b % 1024, swz = sb ^ (((sb >> 9) & 1) << 5); R = (st >> 1) * 16 + swz / 64; C = (st & 1) * 32 + (swz % 64) / 2; }
__host__ __device__ __forceinline__ int perm32(int rho) { const int n = rho >> 4, i = rho & 15; return 8 * (i >> 2) + 4 * n + (i & 3); }

struct Unit { int pm, pn; };
struct Gemm { const bf16_t* A; const bf16_t* Bt; int M, N, K; };

struct StaticOrder {
    int nM, nN, nwg, G, c;
    __host__ __device__ void init(int M, int N, int G_, int c_) { nM = M / BM; nN = N / BM; nwg = nM * nN; G = G_; c = c_; }
    __host__ __device__ bool next(int i, Unit& u) const {
        const long L = (long)i * G + c; if (L >= nwg) return false;
        int wgid = (int)L; { const int q = nwg / NXCD, r = nwg % NXCD, xcd = wgid % NXCD, off = wgid / NXCD; wgid = (xcd < r ? xcd * (q + 1) : r * (q + 1) + (xcd - r) * q) + off; }
        const int nig = WGM * nN, gid = wgid / nig, fm = gid * WGM, gsz = (nM - fm) < WGM ? (nM - fm) : WGM;
        u.pm = fm + ((wgid % nig) % gsz); u.pn = (wgid % nig) / gsz; return true;
    }
    __device__ __forceinline__ void a_ready(const Unit&) const {}
    __device__ __forceinline__ void done(const Unit&) const {}
};
struct QkvOrder {
    StaticOrder base; int sec_tiles;
    __host__ __device__ void init(int M, int N3, int G_, int c_) { base.init(M, N3, G_, c_); sec_tiles = N3 / BM; }
    __host__ __device__ bool next(int i, Unit& u) const { const int r = i / 3, sct = i % 3; if (!base.next(r, u)) return false; u.pn += sct * sec_tiles; return true; }
    __device__ __forceinline__ void a_ready(const Unit&) const {}
    __device__ __forceinline__ void done(const Unit&) const {}
};

__device__ __forceinline__ unsigned cvt_pk_bf16(float lo, float hi) { unsigned r; asm volatile("v_cvt_pk_bf16_f32 %0, %1, %2" : "=v"(r) : "v"(lo), "v"(hi)); return r; }
typedef float f32x2 __attribute__((ext_vector_type(2)));
__device__ __forceinline__ f32x2 gelu_pk(f32x2 v) {
    const f32x2 av = __builtin_elementwise_abs(v), d = av * 0.2316418882f + 1.0f;
    f32x2 t; t.x = __builtin_amdgcn_rcpf(d.x); t.y = __builtin_amdgcn_rcpf(d.y);
    f32x2 q = t * 0.5307027145f + (-0.7265760135f); q = q * t + 0.7107068705f; q = q * t + (-0.142248368f); q = q * t + 0.127414796f; q = q * t;
    const f32x2 s = (v * v) * (-0.72134752044f);
    f32x2 e; e.x = __builtin_amdgcn_exp2f(s.x); e.y = __builtin_amdgcn_exp2f(s.y);
    const f32x2 m = v * (q * e), r = v - m;
    f32x2 o; o.x = v.x < 0.f ? m.x : r.x; o.y = v.y < 0.f ? m.y : r.y; return o;
}

typedef unsigned u32x2 __attribute__((ext_vector_type(2)));
__device__ __forceinline__ u32x4 pack8(const f32x4 v0, const f32x4 v1) { u32x4 w; w.x = cvt_pk_bf16(v0[0], v0[1]); w.y = cvt_pk_bf16(v0[2], v0[3]); w.z = cvt_pk_bf16(v1[0], v1[1]); w.w = cvt_pk_bf16(v1[2], v1[3]); return w; }
__device__ __forceinline__ unsigned short bf1(float x) { return (unsigned short)(cvt_pk_bf16(x, x) & 0xffffu); }

struct EpiEvenIn {
    static constexpr bool PERM = true, AFTER_DRAIN = false;
    bf16_t* U; bf16_t* VG; bf16_t* PB;
    __device__ __forceinline__ void operator()(const f32x4 (&acc)[2][2][4][2], const Unit& u, int wr, int wc, int fr, int fq) const {
        const int row0 = u.pm * BM + wr * 64 + fr, colb = u.pn * BM + wc * 32 + 8 * fq;
#pragma unroll
        for (int ai = 0; ai < 2; ++ai)
#pragma unroll
            for (int m = 0; m < 4; ++m) { const size_t row = (size_t)(row0 + ai * HALF + m * 16);
#pragma unroll
                for (int bj = 0; bj < 2; ++bj) { const int col = colb + bj * HALF; f32x4 v0 = acc[ai][bj][m][0], v1 = acc[ai][bj][m][1];
                    if (u.pn < 4) {
                        f32x2 a = gelu_pk((f32x2){v0[0], v0[1]}), b = gelu_pk((f32x2){v0[2], v0[3]}), c = gelu_pk((f32x2){v1[0], v1[1]}), d = gelu_pk((f32x2){v1[2], v1[3]});
                        v0 = (f32x4){a.x, a.y, b.x, b.y}; v1 = (f32x4){c.x, c.y, d.x, d.y};
                        bf16_t* dst = (u.pn < 2) ? (U + row * 512 + col) : (VG + row * 512 + (col - 512));
                        *(u32x4*)dst = pack8(v0, v1);
                    } else if (col < 2688) { *(u32x4*)(PB + row * 1664 + (col - 1024)) = pack8(v0, v1); }
                } }
    }
};
struct EpiY16 {
    static constexpr bool PERM = true, AFTER_DRAIN = false;
    bf16_t* Y; int ldc;
    __device__ __forceinline__ void operator()(const f32x4 (&acc)[2][2][4][2], const Unit& u, int wr, int wc, int fr, int fq) const {
        const int row0 = u.pm * BM + wr * 64 + fr, colb = u.pn * BM + wc * 32 + 8 * fq;
#pragma unroll
        for (int ai = 0; ai < 2; ++ai)
#pragma unroll
            for (int m = 0; m < 4; ++m) { bf16_t* rp = Y + (size_t)(row0 + ai * HALF + m * 16) * ldc + colb;
#pragma unroll
                for (int bj = 0; bj < 2; ++bj) *(u32x4*)(rp + bj * HALF) = pack8(acc[ai][bj][m][0], acc[ai][bj][m][1]); }
    }
};
struct EpiF32 {
    static constexpr bool PERM = true, AFTER_DRAIN = false;
    float* Y; int ldc;
    __device__ __forceinline__ void operator()(const f32x4 (&acc)[2][2][4][2], const Unit& u, int wr, int wc, int fr, int fq) const {
        const int row0 = u.pm * BM + wr * 64 + fr, colb = u.pn * BM + wc * 32 + 8 * fq;
#pragma unroll
        for (int ai = 0; ai < 2; ++ai)
#pragma unroll
            for (int m = 0; m < 4; ++m) { float* rp = Y + (size_t)(row0 + ai * HALF + m * 16) * ldc + colb;
#pragma unroll
                for (int bj = 0; bj < 2; ++bj) { *(f32x4*)(rp + bj * HALF) = acc[ai][bj][m][0]; *(f32x4*)(rp + bj * HALF + 4) = acc[ai][bj][m][1]; } }
    }
};
struct EpiRelu2 {
    static constexpr bool PERM = true, AFTER_DRAIN = false;
    bf16_t* O; int ldc;
    __device__ __forceinline__ void operator()(const f32x4 (&acc)[2][2][4][2], const Unit& u, int wr, int wc, int fr, int fq) const {
        const int row0 = u.pm * BM + wr * 64 + fr, colb = u.pn * BM + wc * 32 + 8 * fq;
#pragma unroll
        for (int ai = 0; ai < 2; ++ai)
#pragma unroll
            for (int m = 0; m < 4; ++m) { bf16_t* rp = O + (size_t)(row0 + ai * HALF + m * 16) * ldc + colb;
#pragma unroll
                for (int bj = 0; bj < 2; ++bj) { f32x4 v0 = acc[ai][bj][m][0], v1 = acc[ai][bj][m][1];
#pragma unroll
                    for (int j = 0; j < 4; ++j) { const float a = v0[j] > 0.f ? v0[j] : 0.f, b = v1[j] > 0.f ? v1[j] : 0.f; v0[j] = a * a; v1[j] = b * b; }
                    *(u32x4*)(rp + bj * HALF) = pack8(v0, v1); } }
    }
};
struct EpiQKV {
    static constexpr bool PERM = true, AFTER_DRAIN = false;
    bf16_t* Q; bf16_t* K1; bf16_t* K4; bf16_t* K16; bf16_t* VB;
    float* kp; float* vp; float* ks; float* vs; const float* rope;
    __device__ __forceinline__ void operator()(const f32x4 (&acc)[2][2][4][2], const Unit& u, int wr, int wc, int fr, int fq) const {
        const int sec = u.pn >> 2, row0 = u.pm * BM + wr * 64 + fr, colb = (u.pn & 3) * BM + wc * 32 + 8 * fq;
        const bool ropew = (sec < 2) && ((wc & 1) == 0), prompt = (u.pm < 64);
        const float QS = 0.125f * 1.4426950408889634f;
#pragma unroll
        for (int ai = 0; ai < 2; ++ai)
#pragma unroll
            for (int m = 0; m < 4; ++m) { const int row = row0 + ai * HALF + m * 16;
                const int posidx = prompt ? (row & 2047) : (2048 + ((row - 16384) & 7));
                f32x4 cs0 = {1.f, 0.f, 1.f, 0.f}, cs1 = cs0, cs2 = cs0, cs3 = cs0;
                if (ropew) { const f32x4* rp = (const f32x4*)(rope + (size_t)posidx * 16); cs0 = rp[0]; cs1 = rp[1]; cs2 = rp[2]; cs3 = rp[3]; }
#pragma unroll
                for (int bj = 0; bj < 2; ++bj) { const int col = colb + bj * HALF; f32x4 v0 = acc[ai][bj][m][0], v1 = acc[ai][bj][m][1];
                    if (ropew) {
                        f32x4 o0, o1;
#pragma unroll
                        for (int j = 0; j < 4; ++j) {
                            auto s0 = __builtin_amdgcn_permlane16_swap(__float_as_uint(v0[j]), __float_as_uint(v0[j]), false, false);
                            auto s1 = __builtin_amdgcn_permlane16_swap(__float_as_uint(v1[j]), __float_as_uint(v1[j]), false, false);
                            o0[j] = __uint_as_float((fq & 1) ? s0[0] : s0[1]); o1[j] = __uint_as_float((fq & 1) ? s1[0] : s1[1]); }
                        if (fq < 2) { const float sg = (fq == 0) ? -1.f : 1.f;
                            v0[0] = v0[0] * cs0[0] + sg * o0[0] * cs0[1]; v0[1] = v0[1] * cs0[2] + sg * o0[1] * cs0[3];
                            v0[2] = v0[2] * cs1[0] + sg * o0[2] * cs1[1]; v0[3] = v0[3] * cs1[2] + sg * o0[3] * cs1[3];
                            v1[0] = v1[0] * cs2[0] + sg * o1[0] * cs2[1]; v1[1] = v1[1] * cs2[2] + sg * o1[1] * cs2[3];
                            v1[2] = v1[2] * cs3[0] + sg * o1[2] * cs3[1]; v1[3] = v1[3] * cs3[2] + sg * o1[3] * cs3[3]; }
                    }
                    if (sec == 0) { *(u32x4*)(Q + (size_t)row * 1024 + col) = pack8(v0 * QS, v1 * QS); }
                    else if (sec == 1) {
                        float* p = prompt ? (kp + (size_t)row * 1024 + col) : (ks + (size_t)(row - 16384) * 1024 + col);
                        *(f32x4*)p = v0; *(f32x4*)(p + 4) = v1;
                        if (prompt) { const int b = row >> 11, pos = row & 2047, hh = col >> 6, dd = col & 63; const size_t bhh = (size_t)(b * 16 + hh); const u32x4 w = pack8(v0, v1);
                            *(u32x4*)(K1 + (bhh * 2048 + pos) * 64 + dd) = w;
                            *(u32x4*)(K4 + ((bhh * 4 + (pos & 3)) * 512 + (pos >> 2)) * 64 + dd) = w;
                            *(u32x4*)(K16 + ((bhh * 16 + (pos & 15)) * 128 + (pos >> 4)) * 64 + dd) = w; }
                    } else {
                        float* p = prompt ? (vp + (size_t)row * 1024 + col) : (vs + (size_t)(row - 16384) * 1024 + col);
                        *(f32x4*)p = v0; *(f32x4*)(p + 4) = v1;
                        if (prompt) *(u32x4*)(VB + (size_t)row * 1024 + col) = pack8(v0, v1);
                    }
                } }
    }
};

template <class Epi, class Sched, bool ALIGN_EPI = false, bool SP2 = false>
__device__ __forceinline__ void gemm_phase(PG8_LAS unsigned char* lds, const Gemm g, const Sched& S, const Epi& E) {
    const int tid = threadIdx.x, wid = __builtin_amdgcn_readfirstlane(tid >> 6), lane = tid & 63, wr = wid >> 2, wc = wid & 3, fr = lane & 15, fq = lane >> 4;
    const int K = g.K, nt = K / BK;
    unsigned voffA[2], voffB[2];
#pragma unroll
    for (int i = 0; i < 2; ++i) { int R, C; stage_rc(tid * 16 + i * 8192, R, C); const int Rb = Epi::PERM ? ((R & ~31) + perm32(R & 31)) : R;
        voffA[i] = (unsigned)(R * K + C) * 2u; voffB[i] = (unsigned)(Rb * K + C) * 2u; }
    const size_t kstep = (size_t)(BK * 2);
    const size_t hstep = (size_t)HALF * K * 2;
    const size_t tstep = 2 * hstep;
    const unsigned ldsw = (unsigned)wid * 1024u;
    const int aoff = lds_byte(wr * 64 + fr, fq * 8), boff = lds_byte(wc * 32 + fr, fq * 8);
#define PG8_SA(b, h) (((b) * 2 + (h)) * HTB)
#define PG8_SB(b, h) ((4 + (b) * 2 + (h)) * HTB)
#define PG8_STAGE(bufoff, gbase, voff) do { _Pragma("unroll") for (int _i = 0; _i < 2; ++_i) \
        __builtin_amdgcn_global_load_lds((const unsigned*)((const char*)(gbase) + (voff)[_i]), (PG8_LAS unsigned*)(lds + (bufoff) + ldsw + _i * 8192), 16, 0, 0); } while (0)
#define PG8_LDA(dst, b, h) do { _Pragma("unroll") for (int m = 0; m < 4; ++m) _Pragma("unroll") for (int k = 0; k < 2; ++k) dst[m][k] = *(const PG8_LAS bf16x8*)(lds + PG8_SA(b, h) + aoff + m * 2048 + k * 1024); } while (0)
#define PG8_LDB(dst, b, h) do { _Pragma("unroll") for (int n = 0; n < 2; ++n) _Pragma("unroll") for (int k = 0; k < 2; ++k) dst[n][k] = *(const PG8_LAS bf16x8*)(lds + PG8_SB(b, h) + boff + n * 2048 + k * 1024); } while (0)
#define PG8_MMA(ai, bj, At, Bt) do { __builtin_amdgcn_s_setprio(1); _Pragma("unroll") for (int m = 0; m < 4; ++m) _Pragma("unroll") for (int n = 0; n < 2; ++n) _Pragma("unroll") for (int k = 0; k < 2; ++k) \
        acc[ai][bj][m][n] = __builtin_amdgcn_mfma_f32_16x16x32_bf16(Bt[n][k], At[m][k], acc[ai][bj][m][n], 0, 0, 0); __builtin_amdgcn_s_setprio(0); } while (0)
#define PG8_WAIT_V(n) asm volatile("s_waitcnt vmcnt(" #n ")" ::: "memory")
#define PG8_WAIT_L(n) asm volatile("s_waitcnt lgkmcnt(" #n ")" ::: "memory")
#define PG8_BAR __builtin_amdgcn_s_barrier()
#define PG8_SCHED __builtin_amdgcn_sched_barrier(0)
    Unit cur, nxt; int ui = 0;
    if (!S.next(0, cur)) return;
    f32x4 acc[2][2][4][2];
#pragma unroll
    for (int a = 0; a < 2; ++a)
#pragma unroll
        for (int b = 0; b < 2; ++b)
#pragma unroll
            for (int m = 0; m < 4; ++m)
#pragma unroll
                for (int n = 0; n < 2; ++n) acc[a][b][m][n] = (f32x4){0.f, 0.f, 0.f, 0.f};
    bf16x8 At[4][2], B0[2][2], B1[2][2];
    const char* cA = (const char*)g.A + (size_t)cur.pm * tstep; const char* cB = (const char*)g.Bt + (size_t)cur.pn * tstep;
    S.a_ready(cur);
    if constexpr (SP2) {
        PG8_STAGE(PG8_SB(0, 0), cB, voffB); PG8_STAGE(PG8_SB(0, 1), cB + hstep, voffB); PG8_STAGE(PG8_SA(0, 0), cA, voffA); PG8_STAGE(PG8_SA(0, 1), cA + hstep, voffA);
        if (wr == 1) PG8_BAR;
        PG8_WAIT_V(2); PG8_BAR;
        PG8_STAGE(PG8_SB(1, 0), cB + kstep, voffB); PG8_STAGE(PG8_SA(1, 0), cA + kstep, voffA); PG8_STAGE(PG8_SB(1, 1), cB + hstep + kstep, voffB);
        PG8_WAIT_V(6); PG8_BAR;
    } else {
        PG8_STAGE(PG8_SB(0, 0), cB, voffB); PG8_STAGE(PG8_SA(0, 0), cA, voffA); PG8_STAGE(PG8_SB(0, 1), cB + hstep, voffB); PG8_STAGE(PG8_SA(0, 1), cA + hstep, voffA);
        if (wr == 1) PG8_BAR;
        PG8_WAIT_V(4); PG8_BAR;
        PG8_STAGE(PG8_SB(1, 0), cB + kstep, voffB); PG8_STAGE(PG8_SA(1, 0), cA + kstep, voffA); PG8_STAGE(PG8_SB(1, 1), cB + hstep + kstep, voffB);
        PG8_WAIT_V(6); PG8_BAR;
    }
    for (;;) {
        const bool has_next = S.next(ui + 1, nxt);
        const char* nA = has_next ? (const char*)g.A + (size_t)nxt.pm * tstep : cA; const char* nB = has_next ? (const char*)g.Bt + (size_t)nxt.pn * tstep : cB;
        for (int t = 0; t < nt; t += 2) {
            const bool last = (t == nt - 2);
            const char* a1 = cA + (size_t)(t + 1) * kstep;
            const char* a2 = last ? nA : cA + (size_t)(t + 2) * kstep; const char* b2 = last ? nB : cB + (size_t)(t + 2) * kstep;
            const char* a3 = a2 + kstep; const char* b3 = b2 + kstep;
            if (last && has_next) S.a_ready(nxt);
            if constexpr (SP2) {
            PG8_LDB(B0, 0, 0); PG8_LDB(B1, 0, 1); PG8_SCHED; PG8_LDA(At, 0, 0); PG8_STAGE(PG8_SA(1, 1), a1 + hstep, voffA);
            PG8_WAIT_V(8); PG8_WAIT_L(0); PG8_BAR; PG8_MMA(0, 0, At, B0); PG8_MMA(0, 1, At, B1); PG8_BAR; PG8_SCHED;
            PG8_LDA(At, 0, 1); PG8_STAGE(PG8_SB(0, 0), b2, voffB); PG8_STAGE(PG8_SB(0, 1), b2 + hstep, voffB); PG8_STAGE(PG8_SA(0, 0), a2, voffA);
            PG8_WAIT_V(8); PG8_WAIT_L(0); PG8_BAR; PG8_MMA(1, 0, At, B0); PG8_MMA(1, 1, At, B1); PG8_BAR; PG8_SCHED;
            PG8_LDB(B0, 1, 0); PG8_LDB(B1, 1, 1); PG8_SCHED; PG8_LDA(At, 1, 0); PG8_STAGE(PG8_SA(0, 1), a2 + hstep, voffA);
            PG8_WAIT_V(8); PG8_WAIT_L(0); PG8_BAR; PG8_MMA(0, 0, At, B0); PG8_MMA(0, 1, At, B1); PG8_BAR; PG8_SCHED;
            PG8_LDA(At, 1, 1); PG8_STAGE(PG8_SB(1, 0), b3, voffB); PG8_STAGE(PG8_SB(1, 1), b3 + hstep, voffB); PG8_STAGE(PG8_SA(1, 0), a3, voffA);
            PG8_WAIT_V(8); PG8_WAIT_L(0); PG8_BAR; PG8_MMA(1, 0, At, B0); PG8_MMA(1, 1, At, B1); PG8_BAR; PG8_SCHED;
            } else {
            PG8_LDB(B0, 0, 0); PG8_SCHED; PG8_LDA(At, 0, 0); PG8_STAGE(PG8_SA(1, 1), a1 + hstep, voffA);
            PG8_WAIT_L(8); PG8_BAR; PG8_WAIT_L(0); PG8_MMA(0, 0, At, B0); PG8_BAR; PG8_SCHED;
            PG8_LDB(B1, 0, 1); PG8_STAGE(PG8_SB(0, 0), b2, voffB);
            PG8_BAR; PG8_WAIT_L(0); PG8_MMA(0, 1, At, B1); PG8_BAR;
            PG8_LDA(At, 0, 1); PG8_STAGE(PG8_SA(0, 0), a2, voffA);
            PG8_BAR; PG8_WAIT_L(0); PG8_MMA(1, 0, At, B0); PG8_BAR; PG8_SCHED;
            PG8_STAGE(PG8_SB(0, 1), b2 + hstep, voffB);
            PG8_WAIT_V(6); PG8_BAR; PG8_MMA(1, 1, At, B1); PG8_BAR;
            PG8_LDB(B0, 1, 0); PG8_SCHED; PG8_LDA(At, 1, 0); PG8_STAGE(PG8_SA(0, 1), a2 + hstep, voffA);
            PG8_WAIT_L(8); PG8_BAR; PG8_WAIT_L(0); PG8_MMA(0, 0, At, B0); PG8_BAR; PG8_SCHED;
            PG8_LDB(B1, 1, 1); PG8_STAGE(PG8_SB(1, 0), b3, voffB);
            PG8_BAR; PG8_WAIT_L(0); PG8_MMA(0, 1, At, B1); PG8_BAR;
            PG8_LDA(At, 1, 1); PG8_STAGE(PG8_SA(1, 0), a3, voffA);
            PG8_BAR; PG8_WAIT_L(0); PG8_MMA(1, 0, At, B0); PG8_BAR; PG8_SCHED;
            PG8_STAGE(PG8_SB(1, 1), b3 + hstep, voffB);
            PG8_WAIT_V(6); PG8_BAR; PG8_MMA(1, 1, At, B1); PG8_BAR;
            }
        }
        if constexpr (ALIGN_EPI) { if (wr == 0) PG8_BAR; }
        if constexpr (!Epi::AFTER_DRAIN) { E(acc, cur, wr, wc, fr, fq); S.done(cur); }
        if (!has_next) break;
#pragma unroll
        for (int a = 0; a < 2; ++a)
#pragma unroll
            for (int b = 0; b < 2; ++b)
#pragma unroll
                for (int m = 0; m < 4; ++m)
#pragma unroll
                    for (int n = 0; n < 2; ++n) acc[a][b][m][n] = (f32x4){0.f, 0.f, 0.f, 0.f};
        cur = nxt; cA = nA; cB = nB; ++ui;
        if constexpr (ALIGN_EPI) { if (wr == 1) PG8_BAR; }
    }
    PG8_WAIT_V(0);
    if constexpr (!ALIGN_EPI) { if (wr == 0) PG8_BAR; }
    PG8_BAR;
    if constexpr (Epi::AFTER_DRAIN) { E.fused(acc, cur, wr, wc, fr, fq, lds, wid, lane); S.done(cur); }
#undef PG8_SA
#undef PG8_SB
#undef PG8_STAGE
#undef PG8_LDA
#undef PG8_LDB
#undef PG8_MMA
#undef PG8_WAIT_V
#undef PG8_WAIT_L
#undef PG8_BAR
#undef PG8_SCHED
}
}

#ifndef PG8_SP2
#define PG8_SP2 true
#endif
#ifndef PG8_ALIGN
#define PG8_ALIGN true
#endif
#ifndef PROBE_DUP_MASK
#define PROBE_DUP_MASK 0
#endif
#ifndef MK_PER_PHASE
#define MK_PER_PHASE 0
#endif

constexpr int NWAVES = 8;
constexpr int D = 1024, DFF = 4096, MP = 16384, MS = 256, M = MP + MS, SEQ = 2048, NB = 8, NSB = 32, DSEQ = 8, DEPTH = 4;
constexpr int EVEN_IN = 2688, EVEN_IN_PAD = 2816, BCOLS = 1664, AW = 512, BW = 512, NROWC = NB + NSB  ;
constexpr float NORM_EPS = 1e-6f, LN_EPS = 1e-5f, GN_EPS = 64e-5f;
enum { I_XP = 0, I_XS, I_SWKV, I_SSHIFT, I_CK, I_CV, I_CP, I_CS, I_ADAW, I_ADAB, I_NMPRE, I_NMPOST, I_NFPRE, I_NFPOST, I_W1, I_W2, I_EVIN, I_EVOUT,
       I_LNG, I_LNB, I_WS, I_BS, I_MU, I_W0, I_RW2, I_A0, I_A2, I_G2, I_KK, I_KA, I_RK, I_LNXG, I_LNXB, I_QKV, I_ODOUT, N_IN };
constexpr size_t O_YP = 0, O_YS = O_YP + (size_t)MP * D, O_WKVP = O_YS + (size_t)MS * D, O_SHP = O_WKVP + 2ull * 8 * 8 * 64 * 64, O_KP = O_SHP + 2ull * 8 * BCOLS,
                 O_VP = O_KP + 2ull * MP * D, O_WKVS = O_VP + 2ull * MP * D, O_SHS = O_WKVS + 2ull * 32 * 8 * 64 * 64, O_KS = O_SHS + 2ull * 32 * BCOLS,
                 O_VS = O_KS + 2ull * MS * D, O_GV = O_VS + 2ull * MS * D, O_END = O_GV + 2ull * MS * AW;
static_assert(O_END == 88213504ull, "output size");

constexpr size_t MiB = 1u << 20;
constexpr size_t WS_CTL = 0, CTL_ZERO_BYTES = 64 * 1024;
constexpr size_t WS_MODS = 2 * MiB;
constexpr size_t WS_ROPE = 6 * MiB;
constexpr size_t WS_TRIL = 7 * MiB;
constexpr size_t WS_W1T = 8 * MiB, WS_W2T = 40 * MiB, WS_WINT = 72 * MiB, WS_WOUTT = 83 * MiB, WS_WQKVT = 87 * MiB, WS_WOT = 99 * MiB;
constexpr size_t WS_HB = 128 * MiB;
constexpr size_t WS_MIX = 161 * MiB;
constexpr size_t WS_Y = 194 * MiB;
constexpr size_t WS_FF = 259 * MiB;
constexpr size_t WS_U = 389 * MiB, WS_VG = 406 * MiB;
constexpr size_t WS_PB = 423 * MiB;
constexpr size_t WS_RW = 529 * MiB;
constexpr size_t WS_DEC = 640 * MiB;
constexpr size_t WS_G = 724 * MiB;
constexpr size_t WS_BON = 757 * MiB;
constexpr size_t WS_OSC = 760 * MiB;
constexpr size_t WS_Q = 389 * MiB, WS_K = 422 * MiB, WS_VT1 = 454 * MiB, WS_VT4 = 486 * MiB, WS_VT16 = 518 * MiB;
constexpr size_t WS_VB = 550 * MiB;
constexpr size_t WS_K4 = 582 * MiB, WS_K16 = 614 * MiB;
constexpr size_t WS_X16 = 794 * MiB;
constexpr size_t WS_END = 828 * MiB;
static_assert(WS_MODS + 4ull * 40 * 6144 * 4 <= WS_ROPE && WS_WOT + 2ull * D * D * 2 <= WS_HB && WS_HB + (size_t)M * D * 2 <= WS_MIX && WS_MIX + (size_t)M * D * 2 <= WS_Y &&
              WS_Y + (size_t)M * D * 4 <= WS_FF && WS_FF + (size_t)M * DFF * 2 <= WS_U && WS_U + (size_t)M * 512 * 2 <= WS_VG && WS_VG + (size_t)M * 512 * 2 <= WS_PB &&
              WS_PB + (size_t)M * BCOLS * 4 <= WS_RW && WS_RW + (size_t)M * 2560 * 2 <= WS_DEC && WS_DEC + (size_t)M * 512 * 4 <= WS_G && WS_G + (size_t)M * 512 * 4 <= WS_BON && WS_BON + (size_t)M * 8 * 16 <= WS_OSC &&
              WS_OSC + (size_t)M * 512 * 4 <= WS_X16 && WS_X16 + (size_t)M * D * 2 <= WS_END && WS_Q + (size_t)M * D * 2 <= WS_K && WS_K + (size_t)MP * D * 2 == WS_VT1 && WS_VT16 + (size_t)MP * D * 2 <= WS_END, "d_ws map");
constexpr int CW_TMO = 0, CW_BAR = 4096;
static_assert((CW_BAR + 3456  ) * 4 <= (int)CTL_ZERO_BYTES, "barrier words inside the memset region");

constexpr int RING_BYTES = 131072, LDSCTL_OFF = RING_BYTES, MISC_OFF = LDSCTL_OFF + 320, LDS_BYTES = 147456;

#define GAS __attribute__((address_space(1)))
#define LAS __attribute__((address_space(3)))
typedef unsigned short bf16;
typedef unsigned v4u __attribute__((ext_vector_type(4)));
typedef unsigned v2u __attribute__((ext_vector_type(2)));
typedef float f32x4 __attribute__((ext_vector_type(4)));
typedef float f32x2 __attribute__((ext_vector_type(2)));
typedef short bf16x8 __attribute__((ext_vector_type(8)));
typedef GAS unsigned gu32;
#define RLX_AGENT __ATOMIC_RELAXED, __HIP_MEMORY_SCOPE_AGENT
#define LDS_WAIT() asm volatile("s_waitcnt lgkmcnt(0)" ::: "memory")
typedef __bf16 bf16x2_hw __attribute__((ext_vector_type(2)));
__device__ __forceinline__ unsigned pk2(float lo, float hi) { const f32x2 v = {lo, hi}; const bf16x2_hw b = __builtin_convertvector(v, bf16x2_hw); return __builtin_bit_cast(unsigned, b); }
__device__ __forceinline__ unsigned f2bf(float f) { return pk2(f, f) & 0xffffu; }
__device__ __forceinline__ float bf2f(unsigned short h) { return __builtin_bit_cast(float, (unsigned)h << 16); }
__device__ __forceinline__ float bflo(unsigned w) { return __builtin_bit_cast(float, w << 16); }
__device__ __forceinline__ float bfhi(unsigned w) { return __builtin_bit_cast(float, w & 0xffff0000u); }
template <int CTRL> __device__ __forceinline__ float dpp(float x) { return __builtin_bit_cast(float, __builtin_amdgcn_mov_dpp(__builtin_bit_cast(int, x), CTRL, 0xf, 0xf, true)); }
constexpr int XOR1 = 0xB1, XOR2 = 0x4E, XOR8 = 0x128, ROR4 = 0x124;
__device__ __forceinline__ float row16_sum(float x) { x += dpp<XOR1>(x); x += dpp<XOR2>(x); x += dpp<ROR4>(x); x += dpp<XOR8>(x); return x; }
__device__ __forceinline__ float xrow16_sum(float x) {
    auto s = __builtin_amdgcn_permlane16_swap(__float_as_uint(x), __float_as_uint(x), false, false); x = __uint_as_float(s[0]) + __uint_as_float(s[1]);
    auto t = __builtin_amdgcn_permlane32_swap(__float_as_uint(x), __float_as_uint(x), false, false); return __uint_as_float(t[0]) + __uint_as_float(t[1]); }
__device__ __forceinline__ float xrow16_max(float x) {
    auto s = __builtin_amdgcn_permlane16_swap(__float_as_uint(x), __float_as_uint(x), false, false); x = fmaxf(__uint_as_float(s[0]), __uint_as_float(s[1]));
    auto t = __builtin_amdgcn_permlane32_swap(__float_as_uint(x), __float_as_uint(x), false, false); return fmaxf(__uint_as_float(t[0]), __uint_as_float(t[1])); }
__device__ __forceinline__ float wave_sum(float x) { return xrow16_sum(row16_sum(x)); }

struct Args { const float* in[N_IN]; float* out; unsigned char* ws; int ph_lo, ph_hi; };
static_assert(sizeof(Args) == N_IN * 8 + 24, "Args has no padding");

#define XB_TMO      128
#define XB_XCNT(j)  (256  + 64 * (j))
#define XB_XSUB(j)  (1280 + 64 * (j))
#define XB_XGEN(j)  (2304 + 64 * (j))
#define XB_TOP      3328
#define XB_TOPGEN   3392
#define XCD_BAR_WORDS 3456
#define XB_SPIN_CAP (1u << 18)

__device__ __forceinline__ unsigned xb_ld(unsigned* p)              { return __hip_atomic_load(p, __ATOMIC_RELAXED, __HIP_MEMORY_SCOPE_AGENT); }
__device__ __forceinline__ unsigned xb_add(unsigned* p, unsigned v) { return __hip_atomic_fetch_add(p, v, __ATOMIC_RELAXED, __HIP_MEMORY_SCOPE_AGENT); }
__device__ __forceinline__ unsigned xb_xcc_id() { return (unsigned)__builtin_amdgcn_s_getreg((3 << 11) | 20) & 0xFu; }
#define XB_SPIN(cond, bar) do { unsigned _sp = 0; while (cond) { __builtin_amdgcn_s_sleep(1); \
    if ((++_sp & 255u) == 0u) { if (xb_ld(&(bar)[XB_TMO])) break; if (_sp > XB_SPIN_CAP) { atomicAdd(&(bar)[XB_TMO], 1u); break; } } } } while (0)

struct XcdBarrier {
    unsigned* bar; unsigned x;
    volatile LAS unsigned* st;
};

__device__ __forceinline__ XcdBarrier xcd_barrier_post(unsigned* bar, volatile LAS unsigned* st) {
    XcdBarrier b; b.bar = bar; b.x = xb_xcc_id(); b.st = st;
    if (threadIdx.x == 0) (void)xb_add(&bar[XB_XCNT(b.x)], 1u);
    return b;
}
__device__ __forceinline__ void xcd_barrier_complete(unsigned* bar, unsigned x, unsigned& nloc, unsigned& nx) {
    const unsigned G = gridDim.x * gridDim.y * gridDim.z;
    unsigned sum, cnt, mine, sp = 0u;
    for (;;) {
        sum = 0u; cnt = 0u; mine = 0u;
#pragma unroll
        for (unsigned j = 0; j < 16; ++j) { const unsigned c = xb_ld(&bar[XB_XCNT(j)]); sum += c; cnt += (c > 0u) ? 1u : 0u; mine = (j == x) ? c : mine; }
        if (sum == G) break;
        __builtin_amdgcn_s_sleep(1);
        if ((++sp & 255u) == 0u) { if (xb_ld(&bar[XB_TMO])) break; if (sp > XB_SPIN_CAP) { atomicAdd(&bar[XB_TMO], 1u); break; } }
    }
    nloc = mine > 0u ? mine : 1u; nx = cnt > 0u ? cnt : 1u;
}

__device__ __forceinline__ void xcd_barrier(const XcdBarrier& b) {
    asm volatile("s_waitcnt vmcnt(0)" ::: "memory");
    __syncthreads();
    if (threadIdx.x == 0) {
        unsigned* bar = b.bar;
        __builtin_amdgcn_s_waitcnt(0);
        unsigned nloc = b.st[0], nx = b.st[1];
        if (nloc == 0u) { xcd_barrier_complete(bar, b.x, nloc, nx); b.st[0] = nloc; b.st[1] = nx; }
        const unsigned old = xb_add(&bar[XB_XSUB(b.x)], 1u);
        const unsigned gen = old / nloc;
        if (old + 1u == (gen + 1u) * nloc) {
            __builtin_amdgcn_fence(__ATOMIC_RELEASE, "agent");
            asm volatile("s_waitcnt vmcnt(0)" ::: "memory");
            const unsigned og = xb_add(&bar[XB_TOP], 1u);
            const unsigned tg = og / nx;
            if (og + 1u == (tg + 1u) * nx) xb_add(&bar[XB_TOPGEN], 1u);
            else XB_SPIN(xb_ld(&bar[XB_TOPGEN]) == tg, bar);
            __builtin_amdgcn_fence(__ATOMIC_ACQUIRE, "agent");
            xb_add(&bar[XB_XGEN(b.x)], 1u);
            asm volatile("s_waitcnt vmcnt(0)" ::: "memory");
        } else {
            XB_SPIN(xb_ld(&bar[XB_XGEN(b.x)]) == gen, bar);
            __builtin_amdgcn_fence(__ATOMIC_ACQUIRE, "agent");
            asm volatile("s_waitcnt vmcnt(0)" ::: "memory");
        }
    }
    __syncthreads();
}

struct Frame {
    LAS unsigned char* lds;
    volatile LAS unsigned* MISC;
    gu32* ctl;
    int tid, lane, wave, vcu, G;
};

__device__ __forceinline__ void p0_transpose_item(const float* W, int K, int N, bf16* WT, LAS float* scr, int item, int lane) {
    const int nblk = N / 32, kb = item / nblk, nb = item % nblk, k0 = 64 * kb, n0 = 32 * nb;
    float tv[32];
#pragma unroll
    for (int i = 0; i < 32; ++i) { const int kk = 2 * i + (lane >> 5); tv[i] = W[(size_t)(k0 + kk) * N + n0 + (lane & 31)]; }
    __builtin_amdgcn_sched_barrier(0);
#pragma unroll
    for (int i = 0; i < 32; ++i) { const int kk = 2 * i + (lane >> 5); scr[kk * 33 + (lane & 31)] = tv[i]; }
    LDS_WAIT(); asm volatile("" ::: "memory");
    const int c = lane & 7;
#pragma unroll
    for (int j = 0; j < 4; ++j) { const int n = (lane >> 3) + 8 * j; const LAS float* s = scr + (8 * c) * 33 + n;
        v4u o; o.x = pk2(s[0 * 33], s[1 * 33]); o.y = pk2(s[2 * 33], s[3 * 33]); o.z = pk2(s[4 * 33], s[5 * 33]); o.w = pk2(s[6 * 33], s[7 * 33]);
        *(GAS v4u*)(WT + (size_t)(n0 + n) * K + k0 + 8 * c) = o; }
    LDS_WAIT(); asm volatile("" ::: "memory");
}
__device__ __forceinline__ void rope_cs(int pos, int i, float& c, float& s) {
    double b = __builtin_sqrt(__builtin_sqrt(__builtin_sqrt(500000.0))); b = 1.0 / b;
    double inv = 1.0; for (int j = 0; j < i; ++j) inv *= b;
    const double ang = (double)pos * inv;
    const double TWO_PI = 6.283185307179586476925286766559, HALF_PI = 1.5707963267948966192313216916398;
    double r = ang - TWO_PI * __builtin_rint(ang / TWO_PI);
    const double qd = __builtin_rint(r / HALF_PI); const int q = (int)qd; const double y = r - qd * HALF_PI, y2 = y * y;
    const double sy = y * (1.0 + y2 * (-1.0 / 6 + y2 * (1.0 / 120 + y2 * (-1.0 / 5040 + y2 * (1.0 / 362880 + y2 * (-1.0 / 39916800 + y2 * (1.0 / 6227020800.0)))))));
    const double cy = 1.0 + y2 * (-0.5 + y2 * (1.0 / 24 + y2 * (-1.0 / 720 + y2 * (1.0 / 40320 + y2 * (-1.0 / 3628800 + y2 * (1.0 / 479001600.0 + y2 * (-1.0 / 87178291200.0)))))));
    const int qq = q & 3; double cc, ss;
    if (qq == 0) { cc = cy; ss = sy; } else if (qq == 1) { cc = -sy; ss = cy; } else if (qq == 2) { cc = -cy; ss = -sy; } else { cc = sy; ss = -cy; }
    c = (float)cc; s = (float)ss;
}
__device__ __forceinline__ void p0_prologue(const Args& A, Frame& F) {
    const int tid = F.tid, lane = F.lane, wave = F.wave;
    constexpr int CP = 2064;
    for (int idx = tid; idx < 48 * 512; idx += NWAVES * 64) { const int n = idx >> 9, k2 = (idx & 511) * 2; unsigned w = 0u;
        if (n < NROWC) { const float* src = (n < NB) ? (A.in[I_CP] + (size_t)n * D) : (A.in[I_CS] + (size_t)(n - NB) * D);
            const float a = src[k2], b = src[k2 + 1]; w = pk2(a / (1.f + __expf(-a)), b / (1.f + __expf(-b))); }
        *(LAS unsigned*)(F.lds + n * CP + k2 * 2) = w; }
    __syncthreads();
    if (wave < 6) {
        const int job = wave * 256 + F.vcu;
        if (job < 1536) {
            const int l = job / 384, jt = job % 384, j = lane & 15, g = lane >> 4;
            const float* W = A.in[I_ADAW] + (size_t)l * D * 6144 + 16 * jt + j;
            f32x4 acc[3]; acc[0] = acc[1] = acc[2] = (f32x4){0.f, 0.f, 0.f, 0.f};
#pragma unroll 1
            for (int s0 = 0; s0 < 32; s0 += 8) {
                float a[8][8];
#pragma unroll
                for (int u = 0; u < 8; ++u)
#pragma unroll
                    for (int e = 0; e < 8; ++e) a[u][e] = W[(size_t)(32 * (s0 + u) + 8 * g + e) * 6144];
                __builtin_amdgcn_sched_barrier(0);
#pragma unroll
                for (int u = 0; u < 8; ++u) { const int s = s0 + u;
                    v4u af; af.x = pk2(a[u][0], a[u][1]); af.y = pk2(a[u][2], a[u][3]); af.z = pk2(a[u][4], a[u][5]); af.w = pk2(a[u][6], a[u][7]);
                    const bf16x8 Afr = __builtin_bit_cast(bf16x8, af);
#pragma unroll
                    for (int nt = 0; nt < 3; ++nt) { const bf16x8 B = *(const LAS bf16x8*)(F.lds + (16 * nt + j) * CP + (32 * s + 8 * g) * 2);
                        acc[nt] = __builtin_amdgcn_mfma_f32_16x16x32_bf16(Afr, B, acc[nt], 0, 0, 0); } }
            }
            const f32x4 bias = *(const f32x4*)(A.in[I_ADAB] + (size_t)l * 6144 + 16 * jt + 4 * g);
            float* mods = (float*)(A.ws + WS_MODS);
#pragma unroll
            for (int nt = 0; nt < 3; ++nt) { const int n = 16 * nt + j; if (n < NROWC) *(f32x4*)(mods + ((size_t)l * NROWC + n) * 6144 + 16 * jt + 4 * g) = acc[nt] + bias; }
        }
    }
    __syncthreads();
    {
        LAS float* scr = (LAS float*)(F.lds + wave * 16384);
        const int gw = F.vcu * NWAVES + wave, NGW = F.G * NWAVES;
        constexpr int I_FF = (D / 64) * (DFF / 32);
        constexpr int I_IN = (D / 64) * (EVEN_IN / 32);
        constexpr int I_SQ = (D / 64) * (D / 32);
        constexpr int I_QK = (D / 64) * (3 * D / 32);
        constexpr int NITEMS = 8 * I_FF + 2 * (I_IN + I_SQ + I_QK + I_SQ);
        for (int it = gw; it < NITEMS; it += NGW) {
            int r = it;
            if (r < 4 * I_FF) { const int l = r / I_FF; p0_transpose_item(A.in[I_W1] + (size_t)l * D * DFF, D, DFF, (bf16*)(A.ws + WS_W1T) + (size_t)l * D * DFF, scr, r % I_FF, lane); continue; } r -= 4 * I_FF;
            if (r < 4 * I_FF) { const int l = r / I_FF; p0_transpose_item(A.in[I_W2] + (size_t)l * D * DFF, DFF, D, (bf16*)(A.ws + WS_W2T) + (size_t)l * D * DFF, scr, r % I_FF, lane); continue; } r -= 4 * I_FF;
            if (r < 2 * I_IN) { const int e = r / I_IN; p0_transpose_item(A.in[I_EVIN] + (size_t)e * D * EVEN_IN, D, EVEN_IN, (bf16*)(A.ws + WS_WINT) + (size_t)e * EVEN_IN_PAD * D, scr, r % I_IN, lane); continue; } r -= 2 * I_IN;
            if (r < 2 * I_SQ) { const int e = r / I_SQ; p0_transpose_item(A.in[I_EVOUT] + (size_t)e * D * D, D, D, (bf16*)(A.ws + WS_WOUTT) + (size_t)e * D * D, scr, r % I_SQ, lane); continue; } r -= 2 * I_SQ;
            if (r < 2 * I_QK) { const int o = r / I_QK; p0_transpose_item(A.in[I_QKV] + (size_t)o * D * 3 * D, D, 3 * D, (bf16*)(A.ws + WS_WQKVT) + (size_t)o * 3 * D * D, scr, r % I_QK, lane); continue; } r -= 2 * I_QK;
            { const int o = r / I_SQ; p0_transpose_item(A.in[I_ODOUT] + (size_t)o * D * D, D, D, (bf16*)(A.ws + WS_WOT) + (size_t)o * D * D, scr, r % I_SQ, lane); }
        }
    }
    const int gt = F.vcu * (NWAVES * 64) + tid, NGT = F.G * NWAVES * 64;
    for (int i = gt; i < 2 * 128 * 1024 / 8; i += NGT) { const int e = i / (128 * 128), r = i % (128 * 128);
        *(v4u*)((bf16*)(A.ws + WS_WINT) + (size_t)e * EVEN_IN_PAD * D + (size_t)EVEN_IN * D + (size_t)r * 8) = (v4u){0u, 0u, 0u, 0u}; }
    for (int i = gt; i < 2 * 4 * 128 * 128; i += NGT) { const int ii = (i >> 7) & 127, jj = i & 127; ((bf16*)(A.ws + WS_TRIL))[i] = (jj <= ii) ? (bf16)f2bf(A.in[I_WS][i]) : (bf16)0; }
    for (int i = gt; i < 2056 * 8; i += NGT) { const int p = i >> 3, k = i & 7; const int pos = (p < 2048) ? p : (8192 + (p - 2048)); float c, s; rope_cs(pos, k, c, s);
        ((float*)(A.ws + WS_ROPE))[2 * i] = c; ((float*)(A.ws + WS_ROPE))[2 * i + 1] = s; }
}

template <int MODE> __device__ __forceinline__ void norm_phase(const Args& A, Frame& F, int l) {
    const int gw = F.vcu * NWAVES + F.wave, NGW = F.G * NWAVES, lane = F.lane;
    bf16* X = (bf16*)(A.ws + WS_X16); const bf16* Y = (const bf16*)(A.ws + WS_Y); bf16* HB = (bf16*)(A.ws + WS_HB); const float* mods = (const float*)(A.ws + WS_MODS);
    const int lh = (MODE == 2) ? l + 1 : l;
    const bool do_h = (MODE != 2) || (l + 1 < DEPTH);
    const float* gpost = (MODE == 1) ? (A.in[I_NMPOST] + (size_t)l * D) : (A.in[I_NFPOST] + (size_t)l * D);
    const float* gpre = (MODE == 1) ? (A.in[I_NFPRE] + (size_t)lh * D) : (A.in[I_NMPRE] + (size_t)(do_h ? lh : 0) * D);
    const int gate_i = (MODE == 1) ? 2 : 5, shift_i = (MODE == 1) ? 3 : 0, scale_i = (MODE == 1) ? 4 : 1;
    const bool affine = (F.G == 256);
    const int nit = affine ? 9 : (M - gw + NGW - 1) / NGW;
    for (int it = 0; it < nit; ++it) {
        int m;
        if (affine) { if (it < 8) m = 64 * F.vcu + F.wave + 8 * it; else { if (F.wave != (F.vcu & 7)) break; m = MP + F.vcu; } }
        else m = gw + it * NGW;
        const int n = (m < MP) ? (m >> 11) : (NB + ((m - MP) >> 3));
        f32x4 x[4];
        if (MODE == 0) {
            const f32x4* src = (const f32x4*)((m < MP) ? (A.in[I_XP] + (size_t)m * D) : (A.in[I_XS] + (size_t)(m - MP) * D)) + lane;
#pragma unroll
            for (int j = 0; j < 4; ++j) x[j] = src[64 * j];
        } else {
            const v2u* yr = (const v2u*)(Y + (size_t)m * D) + lane; const v2u* xr = (const v2u*)(X + (size_t)m * D) + lane;
            const f32x4* gt = (const f32x4*)(mods + ((size_t)l * NROWC + n) * 6144 + gate_i * D) + lane; const f32x4* gp = (const f32x4*)gpost + lane;
            f32x4 y[4]; float ss = 0.f;
#pragma unroll
            for (int j = 0; j < 4; ++j) {
                if (MODE == 2 && m >= MP) {
                    const f32x4* pr = (const f32x4*)((const float*)(A.ws + WS_OSC) + (size_t)(m - MP) * D) + lane + 64 * j;
                    y[j] = (pr[0] + pr[65536]) + (pr[131072] + pr[196608]);
                } else { const v2u yw = yr[64 * j]; y[j] = (f32x4){bflo(yw.x), bfhi(yw.x), bflo(yw.y), bfhi(yw.y)}; }
                ss += (y[j].x * y[j].x + y[j].y * y[j].y) + (y[j].z * y[j].z + y[j].w * y[j].w); }
            const float rs = 1.0f / sqrtf(wave_sum(ss) * (1.f / D) + NORM_EPS);
#pragma unroll
            for (int j = 0; j < 4; ++j) { const v2u xw = xr[64 * j]; x[j] = (f32x4){bflo(xw.x), bfhi(xw.x), bflo(xw.y), bfhi(xw.y)} + gt[64 * j] * (y[j] * rs * gp[64 * j]); }
        }
        if (do_h) { v2u* xo = (v2u*)(X + (size_t)m * D) + lane;
#pragma unroll
            for (int j = 0; j < 4; ++j) { v2u w; w.x = pk2(x[j].x, x[j].y); w.y = pk2(x[j].z, x[j].w); xo[64 * j] = w; }
        } else { f32x4* xo = (f32x4*)(A.out + (size_t)m * D) + lane;
#pragma unroll
            for (int j = 0; j < 4; ++j) xo[64 * j] = x[j]; }
        if (do_h) {
            float ss = 0.f;
#pragma unroll
            for (int j = 0; j < 4; ++j) ss += (x[j].x * x[j].x + x[j].y * x[j].y) + (x[j].z * x[j].z + x[j].w * x[j].w);
            const float rs = 1.0f / sqrtf(wave_sum(ss) * (1.f / D) + NORM_EPS);
            const f32x4* sh = (const f32x4*)(mods + ((size_t)lh * NROWC + n) * 6144 + shift_i * D) + lane;
            const f32x4* sc = (const f32x4*)(mods + ((size_t)lh * NROWC + n) * 6144 + scale_i * D) + lane;
            const f32x4* gp = (const f32x4*)gpre + lane;
            v2u* ho = (v2u*)(HB + (size_t)m * D) + lane;
#pragma unroll
            for (int j = 0; j < 4; ++j) { const f32x4 h = x[j] * rs * gp[64 * j] * (sc[64 * j] + 1.0f) + sh[64 * j]; v2u w; w.x = pk2(h.x, h.y); w.y = pk2(h.z, h.w); ho[64 * j] = w; }
        }
    }
}

__device__ __forceinline__ float sigmoidf_(float x) { return __builtin_amdgcn_rcpf(1.0f + __expf(-x)); }
__device__ __forceinline__ float rwkv_prev(const Args& A, const bf16* PB, int e, int m, int col) {
    if (m < MP) return ((m & 2047) == 0) ? 0.f : bf2f(PB[(size_t)(m - 1) * BCOLS + col]);
    const int t = (m - MP) & 7, b = (m - MP) >> 3;
    return (t == 0) ? A.in[I_SSHIFT][((size_t)e * NSB + b) * BCOLS + col] : bf2f(PB[(size_t)(m - 1) * BCOLS + col]);
}
__device__ __forceinline__ bf16x8 pack_frag(const float (&x)[8]) { v4u w; w.x = pk2(x[0], x[1]); w.y = pk2(x[2], x[3]); w.z = pk2(x[4], x[5]); w.w = pk2(x[6], x[7]); return __builtin_bit_cast(bf16x8, w); }
__device__ __forceinline__ void rwkv_prep(const Args& A, Frame& F, int e) {
    const int tid = F.tid, lane = F.lane, wave = F.wave, il = lane & 15, g = lane >> 4;
    const bf16* PB = (const bf16*)(A.ws + WS_PB); bf16* RW = (bf16*)(A.ws + WS_RW); float* DEC = (float*)(A.ws + WS_DEC); bf16* G = (bf16*)(A.ws + WS_G); float* BON = (float*)(A.ws + WS_BON);
    LAS unsigned char* LW_hi = F.lds; LAS unsigned char* LW_lo = F.lds + 4096; LAS unsigned char* LA = F.lds + 8192; LAS unsigned char* LG = F.lds + 12288;
    const float* mu = A.in[I_MU] + (size_t)e * BCOLS;
    LAS float* CONSTL = (LAS float*)(F.lds + 20480);
    LAS unsigned char* PBL = F.lds + 36864 + wave * 6656;
    LAS unsigned char* OUTL = F.lds + 90112 + wave * 4096;
    for (int i = tid; i < 8 * 512; i += NWAVES * 64) { const int arr = i >> 9, c = i & 511;
        CONSTL[i] = (arr == 0) ? A.in[I_W0][e * BW + c] : (arr == 1) ? A.in[I_A0][e * BW + c] : (arr == 2) ? A.in[I_KK][e * BW + c] : (arr == 3) ? A.in[I_KA][e * BW + c]
                  : (arr == 4) ? A.in[I_RK][e * BW + c] : mu[(arr - 5) * 512 + c]; }
    bf16x8 bw_hi[4], ba[4], bg[4][2];
#pragma unroll
    for (int ct = 0; ct < 4; ++ct) { const int col = 64 * wave + 16 * ct + il; float x[8];
#pragma unroll
        for (int k = 0; k < 8; ++k) x[k] = A.in[I_RW2][((size_t)e * 32 + 8 * g + k) * BW + col];
        bw_hi[ct] = pack_frag(x);
#pragma unroll
        for (int k = 0; k < 8; ++k) x[k] = A.in[I_A2][((size_t)e * 32 + 8 * g + k) * BW + col];
        ba[ct] = pack_frag(x);
#pragma unroll
        for (int s2 = 0; s2 < 2; ++s2) {
#pragma unroll
            for (int k = 0; k < 8; ++k) x[k] = A.in[I_G2][((size_t)e * 64 + 32 * s2 + 8 * g + k) * BW + col];
            bg[ct][s2] = pack_frag(x); } }
#pragma unroll 1
    for (int pass = 0; pass < 2; ++pass) {
        const int m_first = (pass == 0) ? 64 * F.vcu : (MP + 16 * F.vcu), ntok = (pass == 0) ? 64 : 16;
        if (pass == 1 && F.vcu >= 16) break;
#pragma unroll 1
        for (int idx0 = tid; idx0 < ntok * 128; idx0 += 4 * NWAVES * 64) {
            float sa_pb[4], sa_pv[4], sa_sv[4];
#pragma unroll
            for (int u = 0; u < 4; ++u) { const int idx = idx0 + u * (NWAVES * 64), tk = idx >> 7, c = idx & 127, m = m_first + tk, col = 1536 + c;
                sa_pb[u] = bf2f(PB[(size_t)m * BCOLS + col]); sa_pv[u] = bf2f(PB[(size_t)(m > 0 ? m - 1 : 0) * BCOLS + col]);
                sa_sv[u] = (pass == 1) ? A.in[I_SSHIFT][((size_t)e * NSB + ((m - MP) >> 3)) * BCOLS + col] : 0.f; }
            __builtin_amdgcn_sched_barrier(0);
#pragma unroll
            for (int u = 0; u < 4; ++u) { const int idx = idx0 + u * (NWAVES * 64), tk = idx >> 7, c = idx & 127, m = m_first + tk, col = 1536 + c;
                float prev = sa_pv[u];
                if (pass == 0) { if ((m & 2047) == 0) prev = 0.f; } else { if (((m - MP) & 7) == 0) prev = sa_sv[u]; }
                const float xm = sa_pb[u] + mu[col] * (prev - sa_pb[u]);
                if (c < 32) { const float t2 = __expf(2.f * xm), o = 1.f - 2.f * __builtin_amdgcn_rcpf(t2 + 1.f); const unsigned hb = f2bf(o);
                    *(LAS unsigned short*)(LW_hi + tk * 64 + c * 2) = (unsigned short)hb; *(LAS unsigned short*)(LW_lo + tk * 64 + c * 2) = (unsigned short)f2bf(o - __builtin_bit_cast(float, hb << 16)); }
                else if (c < 64) *(LAS unsigned short*)(LA + tk * 64 + (c - 32) * 2) = (unsigned short)f2bf(xm);
                else *(LAS unsigned short*)(LG + tk * 128 + (c - 64) * 2) = (unsigned short)f2bf(sigmoidf_(xm)); }
        }
        __syncthreads();
#pragma unroll 1
        for (int tt = 0; tt < ntok / 16; ++tt) {
            const int tok = 16 * tt + il;
            const bf16x8 aw_hi = *(const LAS bf16x8*)(LW_hi + tok * 64 + g * 16), aw_lo = *(const LAS bf16x8*)(LW_lo + tok * 64 + g * 16), aa = *(const LAS bf16x8*)(LA + tok * 64 + g * 16);
            const bf16x8 ag0 = *(const LAS bf16x8*)(LG + tok * 128 + g * 16), ag1 = *(const LAS bf16x8*)(LG + tok * 128 + 64 + g * 16);
            f32x4 zw[4], za[4], gg[4];
#pragma unroll
            for (int ct = 0; ct < 4; ++ct) { const f32x4 z = {0.f, 0.f, 0.f, 0.f};
                const f32x4 w = __builtin_amdgcn_mfma_f32_16x16x32_bf16(aw_hi, bw_hi[ct], z, 0, 0, 0); zw[ct] = __builtin_amdgcn_mfma_f32_16x16x32_bf16(aw_lo, bw_hi[ct], w, 0, 0, 0);
                za[ct] = __builtin_amdgcn_mfma_f32_16x16x32_bf16(aa, ba[ct], z, 0, 0, 0);
                f32x4 gq = __builtin_amdgcn_mfma_f32_16x16x32_bf16(ag0, bg[ct][0], z, 0, 0, 0); gg[ct] = __builtin_amdgcn_mfma_f32_16x16x32_bf16(ag1, bg[ct][1], gq, 0, 0, 0); }
            const int mt0 = m_first + 16 * tt;
            for (int c = lane; c < 17 * 24; c += 64) { const int rowi = c / 24, rem = c % 24, arr = rem >> 3, ch = rem & 7; int mm = mt0 - 1 + rowi; mm = mm < 0 ? 0 : mm;
                *(LAS v4u*)(PBL + (rowi * 3 + arr) * 128 + ch * 16) = *(const v4u*)(PB + (size_t)mm * BCOLS + arr * 512 + 64 * wave + 8 * ch); }
            asm volatile("" ::: "memory");
#pragma unroll 1
            for (int rp = 0; rp < 4; ++rp) { const int tl = 4 * g + rp, m = mt0 + tl;
                const bool start = (pass == 0) ? ((m & 2047) == 0) : (((m - MP) & 7) == 0);
                float r_[4], kp_[4], v_[4], dec_[4], kk_[4], a_[4]; float ssq = 0.f;
#pragma unroll
                for (int ct = 0; ct < 4; ++ct) { const int cl = 16 * ct + il, col = 64 * wave + cl;
                    const LAS unsigned short* pc = (const LAS unsigned short*)(PBL + ((tl + 1) * 3) * 128) + cl; const LAS unsigned short* pp = (const LAS unsigned short*)(PBL + (tl * 3) * 128) + cl;
                    const float c_r = bf2f(pc[0]), c_k = bf2f(pc[64]), c_v = bf2f(pc[128]); float p_r = bf2f(pp[0]), p_k = bf2f(pp[64]), p_v = bf2f(pp[128]);
                    if (pass == 1) { const float* sq = A.in[I_SSHIFT] + ((size_t)e * NSB + ((m - MP) >> 3)) * BCOLS; const float s0 = sq[col], s1 = sq[512 + col], s2 = sq[1024 + col];
                        if (start) { p_r = s0; p_k = s1; p_v = s2; } }
                    else if (start) { p_r = 0.f; p_k = 0.f; p_v = 0.f; }
                    const float r = c_r + CONSTL[5 * 512 + col] * (p_r - c_r), k = c_k + CONSTL[6 * 512 + col] * (p_k - c_k), v = c_v + CONSTL[7 * 512 + col] * (p_v - c_v);
                    const float z = zw[ct][rp] + CONSTL[col], nz = -z, sp = fmaxf(nz, 0.f) + __logf(1.0f + __expf(-fabsf(nz)));
                    dec_[ct] = __expf(-__expf(-sp - 0.5f));
                    a_[ct] = sigmoidf_(za[ct][rp] + CONSTL[512 + col]);
                    const float kk = k * CONSTL[2 * 512 + col]; kk_[ct] = kk; ssq += kk * kk;
                    kp_[ct] = k * (1.f + (a_[ct] - 1.f) * CONSTL[3 * 512 + col]); r_[ct] = r; v_[ct] = v; }
                ssq = row16_sum(ssq); const float rn = __builtin_amdgcn_rsqf(ssq + 1e-12f);
                float bon = 0.f, br = 0.f, kr = 0.f;
                LAS unsigned char* orec = OUTL + g * 1024;
#pragma unroll
                for (int ct = 0; ct < 4; ++ct) { const int cl = 16 * ct + il, col = 64 * wave + cl; const float kkn = kk_[ct] * rn, bq = kkn * a_[ct];
                    bon += r_[ct] * kp_[ct] * CONSTL[4 * 512 + col]; br += bq * r_[ct]; kr += kp_[ct] * r_[ct];
                    LAS unsigned short* o16 = (LAS unsigned short*)orec + cl;
                    o16[0] = (unsigned short)f2bf(-kkn); o16[64] = (unsigned short)f2bf(bq); o16[128] = (unsigned short)f2bf(kp_[ct]); o16[192] = (unsigned short)f2bf(dec_[ct] * r_[ct]); o16[256] = (unsigned short)f2bf(v_[ct]);
                    ((LAS float*)(orec + 640))[cl] = dec_[ct]; ((LAS unsigned short*)(orec + 896))[cl] = (unsigned short)f2bf(gg[ct][rp]); }
                bon = row16_sum(bon); br = row16_sum(br); kr = row16_sum(kr);
                if (il == 0) *(f32x4*)(BON + ((size_t)m * 8 + wave) * 4) = (f32x4){br, kr, bon, 0.f};
                asm volatile("s_waitcnt lgkmcnt(0)" ::: "memory");
#pragma unroll
                for (int sl = 0; sl < 4; ++sl) { const size_t mo = (size_t)(mt0 + 4 * sl + rp); const v4u x = *(const LAS v4u*)(OUTL + sl * 1024 + lane * 16);
                    unsigned char* dst = (lane < 40) ? ((unsigned char*)(RW + (mo * 8 + wave) * 320) + lane * 16)
                                       : (lane < 56) ? ((unsigned char*)(DEC + (mo * 8 + wave) * 64) + (lane - 40) * 16)
                                                     : ((unsigned char*)(G + mo * BW + 64 * wave) + (lane - 56) * 16);
                    *(v4u*)dst = x; }
                asm volatile("" ::: "memory");
            }
        }
        __syncthreads();
    }
    { const int gt = F.vcu * (NWAVES * 64) + tid, NGT = F.G * NWAVES * 64;
      for (int i = gt; i < NROWC * BCOLS; i += NGT) { const int n = i / BCOLS, c = i % BCOLS;
          if (n < NB) A.out[O_SHP + ((size_t)e * NB + n) * BCOLS + c] = bf2f(PB[((size_t)n * SEQ + SEQ - 1) * BCOLS + c]);
          else A.out[O_SHS + ((size_t)e * NSB + (n - NB)) * BCOLS + c] = bf2f(PB[((size_t)MP + (size_t)(n - NB) * DSEQ + DSEQ - 1) * BCOLS + c]); } }
}

__device__ __forceinline__ void gmlp_prompt_unit(const Args& A, Frame& F, int e, int chunk, int half) {
    const int lane = F.lane, wave = F.wave;
    const bf16* VG = (const bf16*)(A.ws + WS_VG); const bf16* U = (const bf16*)(A.ws + WS_U); bf16* MIX = (bf16*)(A.ws + WS_MIX);
    const bf16* TR = (const bf16*)(A.ws + WS_TRIL) + (size_t)e * 4 * 128 * 128;
    constexpr int VP = 272;
    const int m0 = chunk * 128;
    const float* lng = A.in[I_LNG] + (size_t)e * AW + 256 * half; const float* lnb = A.in[I_LNB] + (size_t)e * AW + 256 * half;
    float gsc[4], gbi[4];
#pragma unroll
    for (int q = 0; q < 4; ++q) { gsc[q] = lng[lane + 64 * q]; gbi[q] = lnb[lane + 64 * q]; }
#pragma unroll 1
    for (int rb = 0; rb < 16; rb += 8) {
        v4u raw[8]; unsigned short hv[8][4];
#pragma unroll
        for (int u = 0; u < 8; ++u) { const bf16* vr = VG + (size_t)(m0 + wave * 16 + rb + u) * AW; raw[u] = *(const v4u*)(vr + 8 * lane);
#pragma unroll
            for (int q = 0; q < 4; ++q) hv[u][q] = vr[256 * half + lane + 64 * q]; }
#pragma unroll
        for (int u = 0; u < 8; ++u) { const int jrow = wave * 16 + rb + u;
            float s = 0.f, s2 = 0.f;
#pragma unroll
            for (int q = 0; q < 4; ++q) { const float a = bflo(raw[u][q]), b = bfhi(raw[u][q]); s += a + b; s2 += a * a + b * b; }
            s = wave_sum(s); s2 = wave_sum(s2);
            const float mean = s * (1.f / AW), var = fmaxf(s2 * (1.f / AW) - mean * mean, 0.f), rstd = 1.0f / sqrtf(var + LN_EPS);
#pragma unroll
            for (int q = 0; q < 4; ++q) { const int c = lane + 64 * q; const float x = bf2f(hv[u][q]);
                *(LAS unsigned short*)(F.lds + c * VP + jrow * 2) = (unsigned short)f2bf((x - mean) * rstd * gsc[q] + gbi[q]); }
        }
    }
    __syncthreads();
    const int i0 = 16 * wave, il = lane & 15, g4 = lane >> 4, nks = (i0 + 15) / 32 + 1;
#pragma unroll
    for (int gi = 0; gi < 2; ++gi) { const int g = 2 * half + gi;
        f32x4 acc[8];
#pragma unroll
        for (int ct = 0; ct < 8; ++ct) acc[ct] = (f32x4){0.f, 0.f, 0.f, 0.f};
        bf16x8 Bfr[4];
#pragma unroll
        for (int s = 0; s < 4; ++s) Bfr[s] = *(const bf16x8*)(TR + ((size_t)g * 128 + i0 + il) * 128 + 32 * s + 8 * g4);
#pragma unroll
        for (int s = 0; s < 4; ++s) { if (s < nks) { const bf16x8 Bf = Bfr[s];
#pragma unroll
            for (int ct = 0; ct < 8; ++ct) { const bf16x8 Af = *(const LAS bf16x8*)(F.lds + (128 * gi + 16 * ct + il) * VP + (32 * s + 8 * g4) * 2);
                acc[ct] = __builtin_amdgcn_mfma_f32_16x16x32_bf16(Af, Bf, acc[ct], 0, 0, 0); }
        } }
        const int tok = i0 + il; const float bsv = A.in[I_BS][((size_t)e * 4 + g) * 128 + tok];
        const size_t rowoff = (size_t)(m0 + tok) * AW + 128 * g + 4 * g4;
#pragma unroll
        for (int ct = 0; ct < 8; ++ct) { const v2u uu = *(const v2u*)(U + rowoff + 16 * ct);
            const float o0 = bflo(uu.x) * (acc[ct][0] + bsv), o1 = bfhi(uu.x) * (acc[ct][1] + bsv), o2 = bflo(uu.y) * (acc[ct][2] + bsv), o3 = bfhi(uu.y) * (acc[ct][3] + bsv);
            v2u w; w.x = pk2(o0, o1); w.y = pk2(o2, o3);
            *(v2u*)(MIX + (size_t)(m0 + tok) * D + 128 * g + 16 * ct + 4 * g4) = w; }
    }
    __syncthreads();
}
__device__ __forceinline__ void gmlp_sample_unit(const Args& A, Frame& F, int e, int b) {
    const int tid = F.tid, lane = F.lane, wave = F.wave, c = tid, g = c >> 7;
    const bf16* VG = (const bf16*)(A.ws + WS_VG); const bf16* U = (const bf16*)(A.ws + WS_U); bf16* MIX = (bf16*)(A.ws + WS_MIX);
    LAS float* red = (LAS float*)F.lds;
    const int m0 = MP + b * DSEQ;
    float v[8];
#pragma unroll
    for (int t = 0; t < 8; ++t) v[t] = bf2f(VG[(size_t)(m0 + t) * AW + c]);
#pragma unroll
    for (int t = 0; t < 8; ++t) { const float s = wave_sum(v[t]), s2 = wave_sum(v[t] * v[t]); if (lane == 0) { red[wave * 16 + t] = s; red[wave * 16 + 8 + t] = s2; } }
    __syncthreads();
    const float lg = A.in[I_LNG][e * AW + c], lb = A.in[I_LNB][e * AW + c];
#pragma unroll
    for (int t = 0; t < 8; ++t) { float s = 0.f, s2 = 0.f;
#pragma unroll
        for (int w = 0; w < 8; ++w) { s += red[w * 16 + t]; s2 += red[w * 16 + 8 + t]; }
        const float mean = s * (1.f / AW), var = fmaxf(s2 * (1.f / AW) - mean * mean, 0.f), rstd = 1.0f / sqrtf(var + LN_EPS);
        v[t] = (v[t] - mean) * rstd * lg + lb;
        A.out[O_GV + (((size_t)e * NSB + b) * DSEQ + t) * AW + c] = v[t]; }
    const float* ws = A.in[I_WS] + ((size_t)e * 4 + g) * 128 * 128; const float* bs = A.in[I_BS] + ((size_t)e * 4 + g) * 128;
#pragma unroll
    for (int i = 0; i < 8; ++i) { float z = bs[i];
#pragma unroll
        for (int jj = 0; jj <= i; ++jj) z += ws[i * 128 + jj] * v[jj];
        ((bf16*)MIX)[(size_t)(m0 + i) * D + c] = (bf16)f2bf(bf2f(U[(size_t)(m0 + i) * AW + c]) * z); }
    __syncthreads();
}

struct ScanOps { f32x4 aq01, aq23, w4, b4, k4, rr; };
__device__ __forceinline__ ScanOps scan_load(const LAS float* rec  , int ks, const LAS float* rrec  ) {
    ScanOps o; o.aq01 = *(const LAS f32x4*)(rec + 8 * ks); o.aq23 = *(const LAS f32x4*)(rec + 8 * ks + 4); o.w4 = *(const LAS f32x4*)(rec + 128 + 4 * ks);
    o.b4 = *(const LAS f32x4*)(rec + 192 + 4 * ks); o.k4 = *(const LAS f32x4*)(rec + 256 + 4 * ks); o.rr = *(const LAS f32x4*)rrec; return o;
}
__device__ __forceinline__ float scan_step(f32x4& S, const ScanOps& p) {
    f32x2 acc = (f32x2){p.aq01[0], p.aq01[1]} * S[0];
    acc = (f32x2){p.aq01[2], p.aq01[3]} * S[1] + acc;
    acc = (f32x2){p.aq23[0], p.aq23[1]} * S[2] + acc;
    acc = (f32x2){p.aq23[2], p.aq23[3]} * S[3] + acc;
    const f32x4 u = S * p.w4 + p.k4 * p.rr[0];
    float p1 = acc.x, p2 = acc.y;
    p1 += dpp<XOR1>(p1); p2 += dpp<XOR1>(p2); p1 += dpp<XOR2>(p1); p2 += dpp<XOR2>(p2);
    p1 += dpp<ROR4>(p1); p2 += dpp<ROR4>(p2); p1 += dpp<XOR8>(p1); p2 += dpp<XOR8>(p2);
    S = p.b4 * p1 + u;
    return __builtin_fmaf(p1, p.rr[1], __builtin_fmaf(p.rr[0], p.rr[2], p2));
}
__device__ __forceinline__ void scan_prompt(const Args& A, Frame& F, int e) {
    const int tid = F.tid, lane = F.lane, wave = F.wave;
    const int b = F.vcu >> 5, h = (F.vcu >> 2) & 7, q = F.vcu & 3;
    const bf16* RW = (const bf16*)(A.ws + WS_RW); const float* DEC = (const float*)(A.ws + WS_DEC); const float* SCL = (const float*)(A.ws + WS_BON); float* OSC = (float*)(A.ws + WS_OSC);
    constexpr int BLK = 32, BUFB = BLK * 1536;
    LAS unsigned char* buf0 = F.lds; LAS float* obuf = (LAS float*)(F.lds + 2 * BUFB);
    LAS float* dump = obuf + 1024;
    const size_t mbase = (size_t)b * SEQ;
    const bool loader = wave >= 4; const int ltid = tid - 256;
    const int ks = lane & 15, rl = 4 * (wave & 3) + (lane >> 4), row = 16 * q + rl;
    f32x4 S = {0.f, 0.f, 0.f, 0.f};
    v4u la, lq, lbk[2]; f32x4 ld[2]; unsigned short lv[2]; f32x2 lsc[2];
    const int ast = ltid >> 3, ac8 = ltid & 7;
    int bsrc[2], bdst[2], dsrc[2], ddst[2];
#pragma unroll
    for (int i = 0; i < 2; ++i) { const int idx = ltid + 256 * i, st = idx >> 4, r2 = idx & 15, arr = 1 + (r2 >> 3), c8 = r2 & 7;
        bsrc[i] = (st * 8) * 320 + arr * 64 + 8 * c8; bdst[i] = (st * 384 + 128 + 64 * arr + 8 * c8) * 4;
        const int c4 = idx & 15; dsrc[i] = (st * 8) * 64 + 4 * c4; ddst[i] = (st * 384 + 128 + 4 * c4) * 4; }
    const bf16* RWh = RW + (mbase * 8 + h) * 320; const float* DEh = DEC + (mbase * 8 + h) * 64; const float* SCh = SCL + (mbase * 8 + h) * 4;
#define SCAN_LOAD(blk_) do { const bf16* rb_ = RWh + (size_t)(blk_) * (BLK * 8 * 320); \
        la = *(const v4u*)(rb_ + (ast * 8) * 320 + 8 * ac8); lq = *(const v4u*)(rb_ + (ast * 8) * 320 + 192 + 8 * ac8); \
        _Pragma("unroll") for (int i = 0; i < 2; ++i) { const int idx_ = ltid + 256 * i, st_ = idx_ >> 4, r_ = idx_ & 15; lbk[i] = *(const v4u*)(rb_ + bsrc[i]); \
            ld[i] = *(const f32x4*)(DEh + (size_t)(blk_) * (BLK * 8 * 64) + dsrc[i]); \
            lv[i] = rb_[(size_t)st_ * (8 * 320) + 256 + 16 * q + r_]; lsc[i] = *(const f32x2*)(SCh + ((size_t)(blk_) * BLK + st_) * 32); } } while (0)
#define SCAN_PUT(bufi_) do { LAS unsigned char* bb_ = buf0 + (size_t)(bufi_) * BUFB; LAS unsigned char* aq_ = bb_ + (ast * 384 + 16 * ac8) * 4; \
        *(LAS f32x4*)(aq_) = (f32x4){bflo(la.x), bflo(lq.x), bfhi(la.x), bfhi(lq.x)}; *(LAS f32x4*)(aq_ + 16) = (f32x4){bflo(la.y), bflo(lq.y), bfhi(la.y), bfhi(lq.y)}; \
        *(LAS f32x4*)(aq_ + 32) = (f32x4){bflo(la.z), bflo(lq.z), bfhi(la.z), bfhi(lq.z)}; *(LAS f32x4*)(aq_ + 48) = (f32x4){bflo(la.w), bflo(lq.w), bfhi(la.w), bfhi(lq.w)}; \
        _Pragma("unroll") for (int i = 0; i < 2; ++i) { const int idx_ = ltid + 256 * i, st_ = idx_ >> 4, r_ = idx_ & 15; LAS unsigned char* d_ = bb_ + bdst[i]; \
            *(LAS f32x4*)d_ = (f32x4){bflo(lbk[i].x), bfhi(lbk[i].x), bflo(lbk[i].y), bfhi(lbk[i].y)}; *(LAS f32x4*)(d_ + 16) = (f32x4){bflo(lbk[i].z), bfhi(lbk[i].z), bflo(lbk[i].w), bfhi(lbk[i].w)}; \
            *(LAS f32x4*)(bb_ + ddst[i]) = ld[i]; \
            *(LAS f32x4*)(bb_ + (st_ * 384 + 320 + 4 * r_) * 4) = (f32x4){bf2f(lv[i]), lsc[i][0], lsc[i][1], 0.f}; } } while (0)
#define SCAN_BAR() do { asm volatile("s_waitcnt lgkmcnt(0)" ::: "memory"); __builtin_amdgcn_s_barrier(); asm volatile("" ::: "memory"); } while (0)
    if (loader) { SCAN_LOAD(0); SCAN_PUT(0); SCAN_LOAD(1); }
    SCAN_BAR();
    for (int blk = 0; blk < SEQ / BLK; ++blk) {
        const int cur = blk & 1;
        if (loader) {
            if (blk + 1 < SEQ / BLK) SCAN_PUT(cur ^ 1);
            if (blk + 2 < SEQ / BLK) SCAN_LOAD(blk + 2);
            if (blk > 0) {
#pragma unroll
                for (int i = 0; i < 2; ++i) { const int idx = ltid + 256 * i, st = idx >> 4, r16 = idx & 15;
                    OSC[(mbase + (size_t)(blk - 1) * BLK + st) * BW + h * 64 + 16 * q + r16] = obuf[(cur ^ 1) * 512 + idx]; } }
        } else {
            const LAS float* rec0 = (const LAS float*)(buf0 + (size_t)cur * BUFB);
            LAS float* od = (ks == 0) ? (obuf + cur * 512 + rl) : (dump + lane);
            const int ostep = (ks == 0) ? 16 : 0;
            const unsigned vq = (unsigned)(uintptr_t)(rec0 + 8 * ks), vv = (unsigned)(uintptr_t)(rec0 + 4 * ks), ra = (unsigned)(uintptr_t)(rec0 + 320 + 4 * rl);
            ScanOps ring[3];
#define SCAN_ASMLOAD(dst_, st_) asm volatile("ds_read_b128 %0, %6 offset:%9\n\tds_read_b128 %1, %6 offset:%10\n\tds_read_b128 %2, %7 offset:%11\n\tds_read_b128 %3, %7 offset:%12\n\tds_read_b128 %4, %7 offset:%13\n\tds_read_b128 %5, %8 offset:%9" \
                : "=&v"((dst_).aq01), "=&v"((dst_).aq23), "=&v"((dst_).w4), "=&v"((dst_).b4), "=&v"((dst_).k4), "=&v"((dst_).rr) : "v"(vq), "v"(vv), "v"(ra), \
                  "n"((st_) * 1536), "n"((st_) * 1536 + 16), "n"((st_) * 1536 + 512), "n"((st_) * 1536 + 768), "n"((st_) * 1536 + 1024) : "memory")
            SCAN_ASMLOAD(ring[0], 0); SCAN_ASMLOAD(ring[1], 1);
#pragma unroll
            for (int st = 0; st < BLK; ++st) {
#define SCAN_WAIT(N_, r_) asm volatile("s_waitcnt lgkmcnt(" #N_ ")" : "+v"((r_).aq01), "+v"((r_).aq23), "+v"((r_).w4), "+v"((r_).b4), "+v"((r_).k4), "+v"((r_).rr) :: "memory")
                if (st + 2 < BLK) { SCAN_ASMLOAD(ring[(st + 2) % 3], (st + 2 < BLK ? st + 2 : BLK - 1)); SCAN_WAIT(12, ring[st % 3]); }
                else if (st + 1 < BLK) SCAN_WAIT(6, ring[st % 3]);
                else SCAN_WAIT(0, ring[st % 3]);
#undef SCAN_WAIT
                const float o = scan_step(S, ring[st % 3]); od[st * ostep] = o; }
#undef SCAN_ASMLOAD
        }
        SCAN_BAR();
    }
#undef SCAN_LOAD
#undef SCAN_PUT
#undef SCAN_BAR
    if (loader) {
#pragma unroll
        for (int i = 0; i < 2; ++i) { const int idx = ltid + 256 * i, st = idx >> 4, r16 = idx & 15;
            OSC[(mbase + (size_t)(SEQ - BLK) + st) * BW + h * 64 + 16 * q + r16] = obuf[((SEQ / BLK - 1) & 1) * 512 + idx]; }
    } else {
        *(f32x4*)(A.out + O_WKVP + ((((size_t)e * NB + b) * 8 + h) * 64 + row) * 64 + 4 * ks) = S;
    }
    __syncthreads();
}
__device__ __forceinline__ void scan_sample(const Args& A, Frame& F, int e, int sb, int h) {
    const int tid = F.tid, lane = F.lane, wave = F.wave;
    const bf16* RW = (const bf16*)(A.ws + WS_RW); const float* DEC = (const float*)(A.ws + WS_DEC); const float* SCL = (const float*)(A.ws + WS_BON); float* OSC = (float*)(A.ws + WS_OSC);
    constexpr int REC = 320 + 256;
    LAS float* ob = (LAS float*)F.lds;
    const size_t m0 = (size_t)MP + (size_t)sb * DSEQ;
    for (int idx = tid; idx < 8 * 256; idx += NWAVES * 64) { const int st = idx >> 8, r2 = idx & 255, arr = r2 >> 6, c = r2 & 63;
        const float val = bf2f(RW[((m0 + st) * 8 + h) * 320 + r2]);
        ob[st * REC + ((arr == 0) ? 2 * c : (arr == 3) ? 2 * c + 1 : 128 + 64 * arr + c)] = val; }
    { const int st = tid >> 6, c = tid & 63; ob[st * REC + 128 + c] = DEC[((m0 + st) * 8 + h) * 64 + c];
      const f32x2 bk = *(const f32x2*)(SCL + ((m0 + st) * 8 + h) * 4);
      *(LAS f32x4*)(ob + st * REC + 320 + 4 * c) = (f32x4){bf2f(RW[((m0 + st) * 8 + h) * 320 + 256 + c]), bk[0], bk[1], 0.f}; }
    __syncthreads();
    const int ks = lane & 15;
#pragma unroll
    for (int p = 0; p < 2; ++p) { const int row = 32 * p + 4 * wave + (lane >> 4);
        const size_t sidx = ((((size_t)e * NSB + sb) * 8 + h) * 64 + row) * 64 + 4 * ks;
        f32x4 S = *(const f32x4*)(A.in[I_SWKV] + sidx);
#pragma unroll
        for (int st = 0; st < 8; ++st) { const ScanOps c = scan_load(ob + st * REC, ks, ob + st * REC + 320 + 4 * row); const float o = scan_step(S, c); if (ks == 0) OSC[(m0 + st) * BW + h * 64 + row] = o; }
        *(f32x4*)(A.out + O_WKVS + sidx) = S; }
    __syncthreads();
}
__device__ __forceinline__ void rwkv_finalize(const Args& A, Frame& F, int e) {
    const int j = F.tid, lane = F.lane, wave = F.wave;
    const bf16* RW = (const bf16*)(A.ws + WS_RW); const float* OSC = (const float*)(A.ws + WS_OSC); const bf16* G = (const bf16*)(A.ws + WS_G); const float* BON = (const float*)(A.ws + WS_BON);
    bf16* MIX = (bf16*)(A.ws + WS_MIX);
    const float lg = A.in[I_LNXG][e * BW + j], lb = A.in[I_LNXB][e * BW + j];
#pragma unroll 1
    for (int pass = 0; pass < 2; ++pass) {
        if (pass == 1 && (F.vcu < 16 || F.vcu >= 32)) break;
        const int m_lo = (pass == 0) ? 64 * F.vcu : (MP + 16 * (F.vcu - 16)), m_hi = m_lo + ((pass == 0) ? 64 : 16);
        float o_[8], g_[8], bn_[8]; unsigned short v_[8], gq_[8];
#define FIN_LOAD(mb_) do { const float* op = OSC + (size_t)(mb_) * BW + j; const bf16* vp = RW + ((size_t)(mb_) * 8 + wave) * 320 + 256 + lane; const bf16* gp = G + (size_t)(mb_) * BW + j; \
            const float* bp = BON + ((size_t)(mb_) * 8 + wave) * 4 + 2; _Pragma("unroll") for (int u = 0; u < 8; ++u) { o_[u] = op[u * BW]; v_[u] = vp[u * 2560]; gq_[u] = gp[u * BW]; bn_[u] = bp[u * 32]; } } while (0)
        FIN_LOAD(m_lo);
#pragma unroll 1
        for (int mb = m_lo; mb < m_hi; mb += 8) {
            float co[8], cv[8], cg[8], cb[8];
#pragma unroll
            for (int u = 0; u < 8; ++u) { co[u] = o_[u]; cv[u] = bf2f(v_[u]); cg[u] = bf2f(gq_[u]); cb[u] = bn_[u]; }
            if (mb + 8 < m_hi) FIN_LOAD(mb + 8);
            __builtin_amdgcn_sched_barrier(0);
#pragma unroll
            for (int u = 0; u < 8; ++u) {
                const float mean = wave_sum(co[u]) * (1.f / 64.f), dd = co[u] - mean, var = wave_sum(dd * dd) * (1.f / 64.f);
                const float on = dd * __builtin_amdgcn_rsqf(var + GN_EPS) * lg + lb;
                MIX[(size_t)(mb + u) * D + 512 + j] = (bf16)f2bf((on + cb[u] * cv[u]) * cg[u]); }
        }
#undef FIN_LOAD
    }
}

__device__ __forceinline__ const char* uniform_ptr(const char* p) { const unsigned long long v = (unsigned long long)p;
    const unsigned lo = __builtin_amdgcn_readfirstlane((unsigned)v), hi = __builtin_amdgcn_readfirstlane((unsigned)(v >> 32)); return (const char*)(((unsigned long long)hi << 32) | lo); }
template <int DIL> __device__ __forceinline__ void attn_subblock(const bf16* __restrict__ Q, const bf16* __restrict__ K, const bf16* __restrict__ VT, int b, int h, int cls, int mq0,
                                                              int lane, f32x4 (&oacc)[2][4], float (&lse2)[2]) {
    constexpr int SUBLEN = SEQ / DIL;
    const int il = lane & 15, g = lane >> 4;
    const int kbase = mq0 - 128;
    const int g0 = (kbase < 0) ? ((-kbase) >> 5) : 0;
    const char* qb = (const char*)(Q + ((size_t)b * SEQ + (size_t)mq0 * DIL + cls) * D + h * 64);
    const char* kb = (const char*)K + (((long)((b * 16 + h) * DIL + cls)) * SUBLEN + kbase) * 128;
    const char* vb = (const char*)VT + ((((long)((b * 16 + h) * DIL + cls)) * (SUBLEN / 16) + (kbase >> 4)) * 64) * 32;
    qb = uniform_ptr(qb); kb = uniform_ptr(kb); vb = uniform_ptr(vb);
    unsigned qoff = (unsigned)(il * DIL * D + 8 * g) * 2u, koff = (unsigned)((8 * (il >> 2) + (il & 3)) * 128 + 16 * g), voff = (unsigned)((g >> 1) * 2048 + il * 32 + (g & 1) * 16);
    asm volatile("" : "+v"(qoff), "+v"(koff), "+v"(voff));
    bf16x8 qf[2][2], kf[5][2][2]; v4u vf[4][5];
#pragma unroll
    for (int tq = 0; tq < 2; ++tq) { qf[tq][0] = *(const bf16x8*)(qb + (qoff + (unsigned)(tq * 16 * DIL * D * 2))); qf[tq][1] = *(const bf16x8*)(qb + (qoff + (unsigned)(tq * 16 * DIL * D * 2) + 64u)); }
#pragma unroll
    for (int G = 0; G < 5; ++G) {
        if (G == 4 || G >= g0) {
#pragma unroll
            for (int hf = 0; hf < 2; ++hf) { const unsigned c = (unsigned)((32 * G + 4 * hf) * 128);
                kf[G][hf][0] = *(const bf16x8*)(kb + (koff + c)); kf[G][hf][1] = *(const bf16x8*)(kb + (koff + c + 64u)); }
        } else {
#pragma unroll
            for (int hf = 0; hf < 2; ++hf) { kf[G][hf][0] = (bf16x8){0, 0, 0, 0, 0, 0, 0, 0}; kf[G][hf][1] = (bf16x8){0, 0, 0, 0, 0, 0, 0, 0}; }
        }
    }
#define ATT_VLOAD(dt0, dt1) do { _Pragma("unroll") for (int G = 0; G < 5; ++G) { if (G == 4 || G >= g0) { _Pragma("unroll") for (int dt = (dt0); dt < (dt1); ++dt) \
        vf[dt][G] = *(const v4u*)(vb + (voff + (unsigned)(2 * G * 2048 + 16 * dt * 32))); } else { _Pragma("unroll") for (int dt = (dt0); dt < (dt1); ++dt) vf[dt][G] = (v4u){0u, 0u, 0u, 0u}; } } } while (0)
    ATT_VLOAD(0, 2);
    __builtin_amdgcn_sched_barrier(0);
    bf16x8 pf[2][5]; float rsum[2];
#pragma unroll
    for (int tq = 0; tq < 2; ++tq) {
        f32x4 sc[5][2];
#pragma unroll
        for (int G = 0; G < 5; ++G)
#pragma unroll
            for (int hf = 0; hf < 2; ++hf) { f32x4 a = {0.f, 0.f, 0.f, 0.f};
                a = __builtin_amdgcn_mfma_f32_16x16x32_bf16(kf[G][hf][0], qf[tq][0], a, 0, 0, 0);
                a = __builtin_amdgcn_mfma_f32_16x16x32_bf16(kf[G][hf][1], qf[tq][1], a, 0, 0, 0);
                sc[G][hf] = a; }
        __builtin_amdgcn_sched_barrier(0);
        if (tq == 1) { ATT_VLOAD(2, 4); __builtin_amdgcn_sched_barrier(0); }
        int t = 8 * g - il - 16 * tq; asm volatile("" : "+v"(t));
#pragma unroll
        for (int hf = 0; hf < 2; ++hf)
#pragma unroll
            for (int r = 0; r < 4; ++r) { if (!(t + (4 * hf + r) >= 0)) sc[0][hf][r] = -INFINITY; if (!(t + (128 + 4 * hf + r) <= 128)) sc[4][hf][r] = -INFINITY; }
        if (g0 > 0) {
#pragma unroll
            for (int G = 0; G < 4; ++G) { const bool dead = G < g0;
#pragma unroll
                for (int hf = 0; hf < 2; ++hf)
#pragma unroll
                    for (int r = 0; r < 4; ++r) if (dead) sc[G][hf][r] = -INFINITY; }
        }
        float mx = -INFINITY;
#pragma unroll
        for (int G = 0; G < 5; ++G)
#pragma unroll
            for (int hf = 0; hf < 2; ++hf)
#pragma unroll
                for (int r = 0; r < 4; ++r) mx = fmaxf(mx, sc[G][hf][r]);
        mx = xrow16_max(mx);
        float sum = 0.f;
#pragma unroll
        for (int G = 0; G < 5; ++G) { float p[8];
#pragma unroll
            for (int hf = 0; hf < 2; ++hf)
#pragma unroll
                for (int r = 0; r < 4; ++r) { const float e = __builtin_amdgcn_exp2f(sc[G][hf][r] - mx); p[4 * hf + r] = e; sum += e; }
            v4u w; w.x = pk2(p[0], p[1]); w.y = pk2(p[2], p[3]); w.z = pk2(p[4], p[5]); w.w = pk2(p[6], p[7]); pf[tq][G] = __builtin_bit_cast(bf16x8, w); }
        sum = xrow16_sum(sum);
        rsum[tq] = __builtin_amdgcn_rcpf(sum);
        lse2[tq] = mx + __builtin_amdgcn_logf(sum);
        __builtin_amdgcn_sched_barrier(0);
    }
#undef ATT_VLOAD
#pragma unroll
    for (int tq = 0; tq < 2; ++tq)
#pragma unroll
        for (int dt = 0; dt < 4; ++dt) { f32x4 o = {0.f, 0.f, 0.f, 0.f};
#pragma unroll
            for (int G = 0; G < 5; ++G) o = __builtin_amdgcn_mfma_f32_16x16x32_bf16(__builtin_bit_cast(bf16x8, vf[dt][G]), pf[tq][G], o, 0, 0, 0);
            oacc[tq][dt] = o * rsum[tq]; }
}
template <int STAGE  > __device__ __forceinline__ void attn_combine(LAS float* oimg, LAS float* mimg, int pl, int g, const f32x4 (&o)[4], float lse2, bf16* mixrow) {
    LAS float* orow = oimg + pl * 64; const int sw = (pl ^ (pl >> 2) ^ (pl >> 4)) & 15;
    if (STAGE == 0) {
#pragma unroll
        for (int dt = 0; dt < 4; ++dt) *(LAS f32x4*)(orow + 4 * ((g + 4 * dt) ^ sw)) = o[dt];
        if (g == 0) { mimg[2 * pl] = lse2; mimg[2 * pl + 1] = 1.f; }
    } else {
        const float m0 = mimg[2 * pl], den0 = mimg[2 * pl + 1];
        const float mn = fmaxf(m0, lse2), fa = __builtin_amdgcn_exp2f(m0 - mn), fb = __builtin_amdgcn_exp2f(lse2 - mn), den = den0 * fa + fb;
        if (STAGE == 1) {
#pragma unroll
            for (int dt = 0; dt < 4; ++dt) { LAS f32x4* p = (LAS f32x4*)(orow + 4 * ((g + 4 * dt) ^ sw)); const f32x4 a = *p; *p = a * fa + o[dt] * fb; }
            if (g == 0) { mimg[2 * pl] = mn; mimg[2 * pl + 1] = den; }
        } else {
            const float inv = 1.0f / den;
#pragma unroll
            for (int dt = 0; dt < 4; ++dt) { const f32x4 a = *(LAS f32x4*)(orow + 4 * ((g + 4 * dt) ^ sw)); const f32x4 r = (a * fa + o[dt] * fb) * inv;
                v2u w; w.x = pk2(r[0], r[1]); w.y = pk2(r[2], r[3]); *(v2u*)(mixrow + 16 * dt + 4 * g) = w; }
        }
    }
}
__device__ __forceinline__ void attn_prompt_unit(const Args& A, Frame& F, int unit) {
    const int lane = F.lane, wave = F.wave, il = lane & 15, g = lane >> 4;
    const int bh = unit >> 2, tile = unit & 3, b = bh >> 4, h = bh & 15, P0 = 512 * tile;
    const bf16* Q = (const bf16*)(A.ws + WS_Q); const bf16* K1 = (const bf16*)(A.ws + WS_K); const bf16* K4 = (const bf16*)(A.ws + WS_K4); const bf16* K16 = (const bf16*)(A.ws + WS_K16);
    const bf16* VT1 = (const bf16*)(A.ws + WS_VT1); const bf16* VT4 = (const bf16*)(A.ws + WS_VT4); const bf16* VT16 = (const bf16*)(A.ws + WS_VT16);
    bf16* MIX = (bf16*)(A.ws + WS_MIX);
    LAS float* oimg = (LAS float*)F.lds; LAS float* mimg = (LAS float*)(F.lds + LDSCTL_OFF + 1024);
    f32x4 o[2][4]; float lse2[2];
#pragma unroll 1
    for (int s = 0; s < 2; ++s) { const int cls = 2 * wave + s, mq0 = P0 / 16;
        attn_subblock<16>(Q, K16, VT16, b, h, cls, mq0, lane, o, lse2);
#pragma unroll
        for (int tq = 0; tq < 2; ++tq) attn_combine<0>(oimg, mimg, 16 * (16 * tq + il) + cls, g, o[tq], lse2[tq], nullptr); }
    __syncthreads();
#pragma unroll 1
    for (int s = 0; s < 2; ++s) { const int sb = 2 * wave + s, cls = sb & 3, mq0 = P0 / 4 + 32 * (sb >> 2);
        attn_subblock<4>(Q, K4, VT4, b, h, cls, mq0, lane, o, lse2);
#pragma unroll
        for (int tq = 0; tq < 2; ++tq) attn_combine<1>(oimg, mimg, 128 * (sb >> 2) + 4 * (16 * tq + il) + cls, g, o[tq], lse2[tq], nullptr); }
    __syncthreads();
#pragma unroll 1
    for (int s = 0; s < 2; ++s) { const int sb = 2 * wave + s, mq0 = P0 + 32 * sb;
        attn_subblock<1>(Q, K1, VT1, b, h, 0, mq0, lane, o, lse2);
#pragma unroll
        for (int tq = 0; tq < 2; ++tq) { const int pl = 32 * sb + 16 * tq + il;
            attn_combine<2>(oimg, mimg, pl, g, o[tq], lse2[tq], MIX + ((size_t)b * SEQ + P0 + pl) * D + h * 64); } }
    __syncthreads();
}
__device__ __forceinline__ void vt_build_unit(const Args& A, Frame& F, int unit) {
    const int tid = F.tid;
    const int bh = unit >> 3, tile = unit & 7, b = bh >> 4, h = bh & 15, P0 = 256 * tile;
    const bf16* VB = (const bf16*)(A.ws + WS_VB);
    bf16* VT1 = (bf16*)(A.ws + WS_VT1); bf16* VT4 = (bf16*)(A.ws + WS_VT4); bf16* VT16 = (bf16*)(A.ws + WS_VT16);
    constexpr int LP = 264;
    LAS unsigned short* LT = (LAS unsigned short*)F.lds;
    { const int r = tid >> 1, hf = tid & 1; const bf16* src = VB + ((size_t)b * SEQ + P0 + r) * D + h * 64 + 32 * hf;
      v4u x[4];
#pragma unroll
      for (int i = 0; i < 4; ++i) x[i] = *(const v4u*)(src + 8 * i);
#pragma unroll
      for (int i = 0; i < 4; ++i)
#pragma unroll
          for (int q = 0; q < 4; ++q) { const int dd = 32 * hf + 8 * i + 2 * q; LT[dd * LP + r] = (unsigned short)(x[i][q] & 0xffffu); LT[(dd + 1) * LP + r] = (unsigned short)(x[i][q] >> 16); } }
    __syncthreads();
#pragma unroll
    for (int c = 0; c < 4; ++c) { const int idx = tid + 512 * c, blk = idx >> 7, dd = (idx >> 1) & 63, hf = idx & 1;
        { const v4u w = *(const LAS v4u*)(LT + dd * LP + 16 * blk + 8 * hf);
          *(v4u*)(VT1 + ((((size_t)bh * 128 + P0 / 16 + blk) * 64 + dd) * 16 + 8 * hf)) = w; }
        { const int cls = blk >> 2, mo = 16 * (blk & 3) + 8 * hf; unsigned short e[8];
#pragma unroll
          for (int j = 0; j < 8; ++j) e[j] = LT[dd * LP + 4 * (mo + j) + cls];
          v4u w; w.x = e[0] | ((unsigned)e[1] << 16); w.y = e[2] | ((unsigned)e[3] << 16); w.z = e[4] | ((unsigned)e[5] << 16); w.w = e[6] | ((unsigned)e[7] << 16);
          *(v4u*)(VT4 + (((((size_t)bh * 4 + cls) * 32 + P0 / 64 + (blk & 3)) * 64 + dd) * 16 + 8 * hf)) = w; }
        { const int cls = blk, mo = 8 * hf; unsigned short e[8];
#pragma unroll
          for (int j = 0; j < 8; ++j) e[j] = LT[dd * LP + 16 * (mo + j) + cls];
          v4u w; w.x = e[0] | ((unsigned)e[1] << 16); w.y = e[2] | ((unsigned)e[3] << 16); w.z = e[4] | ((unsigned)e[5] << 16); w.w = e[6] | ((unsigned)e[7] << 16);
          *(v4u*)(VT16 + (((((size_t)bh * 16 + cls) * 8 + P0 / 256) * 64 + dd) * 16 + 8 * hf)) = w; }
    }
    __syncthreads();
}
__device__ __forceinline__ void attn_sample_unit(const Args& A, Frame& F, int o_idx, int su) {
    const int lane = F.lane, t = F.wave, kl = lane & 15, grp = lane >> 4;
    const int sb = su >> 4, h = su & 15;
    const bf16* Q = (const bf16*)(A.ws + WS_Q); bf16* MIX = (bf16*)(A.ws + WS_MIX);
    const float* ck = A.in[I_CK] + (((size_t)o_idx * NSB + sb) * 2048) * D + h * 64 + 4 * kl;
    const float* cv = A.in[I_CV] + (((size_t)o_idx * NSB + sb) * 2048) * D + h * 64 + 4 * kl;
    const float* kn = A.out + O_KS + ((size_t)o_idx * MS + (size_t)sb * DSEQ) * D + h * 64 + 4 * kl;
    const float* vn = A.out + O_VS + ((size_t)o_idx * MS + (size_t)sb * DSEQ) * D + h * 64 + 4 * kl;
    const size_t mrow = (size_t)MP + (size_t)sb * DSEQ + t;
    f32x4 q4; { const v2u qw = *(const v2u*)(Q + mrow * D + h * 64 + 4 * kl); q4 = (f32x4){bflo(qw.x), bfhi(qw.x), bflo(qw.y), bfhi(qw.y)}; }
    f32x4 accO = {0.f, 0.f, 0.f, 0.f}; float mrun = 0.f, den = 0.f;
#pragma unroll 1
    for (int br = 0; br < 3; ++br) { const int dil = (br == 0) ? 1 : (br == 1 ? 4 : 16);
        float sreg[33]; float mx = -INFINITY;
        const int idx0 = 2048 + t - grp * dil;
#pragma unroll
        for (int c0 = 0; c0 < 34; c0 += 17) { f32x4 kk[17];
#pragma unroll
            for (int u = 0; u < 17; ++u) { if (c0 + u < 33) { const int idx = idx0 - 4 * (c0 + u) * dil; const int idc = idx < 0 ? 0 : idx;
                const float* kp = (c0 + u < 2 && idc >= 2048) ? (kn + (size_t)(idc - 2048) * D) : (ck + (size_t)idc * D); kk[u] = *(const f32x4*)kp; } }
            __builtin_amdgcn_sched_barrier(0);
#pragma unroll
            for (int u = 0; u < 17; ++u) { if (c0 + u < 33) { const int j = 4 * (c0 + u) + grp;
                float s = __builtin_fmaf(q4[3], kk[u][3], __builtin_fmaf(q4[2], kk[u][2], __builtin_fmaf(q4[1], kk[u][1], q4[0] * kk[u][0])));
                s = row16_sum(s); s = (j <= 128) ? s : -INFINITY; sreg[c0 + u] = s; mx = fmaxf(mx, s); } }
        }
        mx = xrow16_max(mx);
        float sum = 0.f; f32x4 oa = {0.f, 0.f, 0.f, 0.f};
#pragma unroll
        for (int c0 = 0; c0 < 34; c0 += 17) { f32x4 vv[17];
#pragma unroll
            for (int u = 0; u < 17; ++u) { if (c0 + u < 33) { const int idx = idx0 - 4 * (c0 + u) * dil; const int idc = idx < 0 ? 0 : idx;
                const float* vp = (c0 + u < 2 && idc >= 2048) ? (vn + (size_t)(idc - 2048) * D) : (cv + (size_t)idc * D); vv[u] = *(const f32x4*)vp; } }
            __builtin_amdgcn_sched_barrier(0);
#pragma unroll
            for (int u = 0; u < 17; ++u) { if (c0 + u < 33) { const float p = __builtin_amdgcn_exp2f(sreg[c0 + u] - mx); sum += p; oa += vv[u] * p; } }
        }
        sum = xrow16_sum(sum);
#pragma unroll
        for (int c = 0; c < 4; ++c) oa[c] = xrow16_sum(oa[c]);
        oa = oa * __builtin_amdgcn_rcpf(sum); const float lse2 = mx + __builtin_amdgcn_logf(sum);
        if (br == 0) { accO = oa; mrun = lse2; den = 1.f; }
        else { const float mn = fmaxf(mrun, lse2), fa = __builtin_amdgcn_exp2f(mrun - mn), fb = __builtin_amdgcn_exp2f(lse2 - mn); accO = accO * fa + oa * fb; den = den * fa + fb; mrun = mn; }
    }
    accO = accO * (1.0f / den);
    if (grp == 0) { v2u w; w.x = pk2(accO[0], accO[1]); w.y = pk2(accO[2], accO[3]); *(v2u*)(MIX + mrow * D + h * 64 + 4 * kl) = w; }
}


template <int KS, class Epi> __device__ __forceinline__ void small_gemm(Frame& F, const bf16* __restrict__ Am  , const bf16* __restrict__ Bt  , int N, int K, const Epi& E, int rank, int nrank) {
    constexpr int TPW = 8 / KS;
    const int tid = F.tid, lane = F.lane, wave = F.wave, il = lane & 15, g = lane >> 4;
    const int ntn = N / 32, ntiles = 8 * ntn, kw = K / KS, nks = kw / 32;
    LAS float* P = (LAS float*)F.lds;
    for (int base = rank * TPW; base < ntiles; base += nrank * TPW) {
        const int slot = wave / KS, kpart = wave % KS, tile = base + slot;
        if (tile < ntiles) {
            const int tm = tile & 7, tn = tile >> 3;
            const bf16* ap = Am + (size_t)(32 * tm + il) * K + (size_t)kpart * kw + 8 * g;
            const bf16* bp = Bt + (size_t)(32 * tn + il) * K + (size_t)kpart * kw + 8 * g;
            f32x4 acc[2][2];
#pragma unroll
            for (int i = 0; i < 2; ++i)
#pragma unroll
                for (int j = 0; j < 2; ++j) acc[i][j] = (f32x4){0.f, 0.f, 0.f, 0.f};
#pragma unroll 8
            for (int s2 = 0; s2 < nks; ++s2) {
                const bf16x8 a0 = *(const bf16x8*)(ap + 32 * s2), a1 = *(const bf16x8*)(ap + (size_t)16 * K + 32 * s2);
                const bf16x8 b0 = *(const bf16x8*)(bp + 32 * s2), b1 = *(const bf16x8*)(bp + (size_t)16 * K + 32 * s2);
                acc[0][0] = __builtin_amdgcn_mfma_f32_16x16x32_bf16(a0, b0, acc[0][0], 0, 0, 0); acc[0][1] = __builtin_amdgcn_mfma_f32_16x16x32_bf16(a0, b1, acc[0][1], 0, 0, 0);
                acc[1][0] = __builtin_amdgcn_mfma_f32_16x16x32_bf16(a1, b0, acc[1][0], 0, 0, 0); acc[1][1] = __builtin_amdgcn_mfma_f32_16x16x32_bf16(a1, b1, acc[1][1], 0, 0, 0);
            }
            LAS float* pw = P + (slot * KS + kpart) * 1056;
#pragma unroll
            for (int i = 0; i < 2; ++i)
#pragma unroll
                for (int j = 0; j < 2; ++j)
#pragma unroll
                    for (int r = 0; r < 4; ++r) pw[(16 * i + 4 * g + r) * 33 + 16 * j + il] = acc[i][j][r];
        }
        __syncthreads();
        float sum[2 * TPW];
#pragma unroll
        for (int e2 = 0; e2 < 2 * TPW; ++e2) { const int idx = tid + 512 * e2, sl = idx >> 10, w = idx & 1023, r = w >> 5, c = w & 31; float v = 0.f;
#pragma unroll
            for (int kp = 0; kp < KS; ++kp) v += P[(sl * KS + kp) * 1056 + r * 33 + c];
            sum[e2] = v; }
        if (Epi::NEEDS_TILE) { __syncthreads();
#pragma unroll
            for (int e2 = 0; e2 < 2 * TPW; ++e2) { const int idx = tid + 512 * e2, sl = idx >> 10, w = idx & 1023, r = w >> 5, c = w & 31; P[(sl * KS) * 1056 + r * 33 + c] = sum[e2]; }
            __syncthreads(); }
#pragma unroll
        for (int e2 = 0; e2 < 2 * TPW; ++e2) { const int idx = tid + 512 * e2, sl = idx >> 10, w = idx & 1023, r = w >> 5, c = w & 31, tile = base + sl;
            if (tile < ntiles) E(32 * (tile & 7) + r, 32 * (tile >> 3) + c, sum[e2], P + (sl * KS) * 1056 + r * 33, c); }
        __syncthreads();
    }
}
template <class Epi, int KQ = 1> __device__ __forceinline__ void small_gemm64(Frame& F, const bf16* __restrict__ Am  , const bf16* __restrict__ Bt  , int N, int K, const Epi& E, int rank, int nrank, float* part = nullptr) {
    const int tid = F.tid, lane = F.lane, wave = F.wave, il = lane & 15, g = lane >> 4;
    const int ntiles = 4 * (N / 64), kw = K / (8 * KQ), nks = kw / 32;
    LAS float* P = (LAS float*)F.lds;
    for (int item = rank; item < ntiles * KQ; item += nrank) {
        const int tile = item / KQ, kq = item % KQ, tm = tile & 3, tn = tile >> 2;
        const bf16* ap = Am + (size_t)(64 * tm + il) * K + (size_t)(kq * 8 + wave) * kw + 8 * g;
        const bf16* bp = Bt + (size_t)(64 * tn + il) * K + (size_t)(kq * 8 + wave) * kw + 8 * g;
        f32x4 acc[4][4];
#pragma unroll
        for (int i = 0; i < 4; ++i)
#pragma unroll
            for (int j = 0; j < 4; ++j) acc[i][j] = (f32x4){0.f, 0.f, 0.f, 0.f};
        bf16x8 fa[2][1][4], fb[2][1][4];
#define SG_LOAD(buf_, s0_) do { _Pragma("unroll") for (int u = 0; u < 1; ++u) _Pragma("unroll") for (int i = 0; i < 4; ++i) { \
            fa[buf_][u][i] = *(const bf16x8*)(ap + (size_t)(16 * i) * K + 32 * ((s0_) + u)); fb[buf_][u][i] = *(const bf16x8*)(bp + (size_t)(16 * i) * K + 32 * ((s0_) + u)); } } while (0)
#define SG_MMA(buf_) do { _Pragma("unroll") for (int u = 0; u < 1; ++u) _Pragma("unroll") for (int i = 0; i < 4; ++i) _Pragma("unroll") for (int j = 0; j < 4; ++j) \
            acc[i][j] = __builtin_amdgcn_mfma_f32_16x16x32_bf16(fa[buf_][u][i], fb[buf_][u][j], acc[i][j], 0, 0, 0); } while (0)
        SG_LOAD(0, 0);
#pragma unroll 1
        for (int s0 = 0; s0 < nks; s0 += 2) {
            SG_LOAD(1, s0 + 1);
            __builtin_amdgcn_sched_barrier(0);
            SG_MMA(0);
            __builtin_amdgcn_sched_barrier(0);
            if (s0 + 2 < nks) SG_LOAD(0, s0 + 2);
            __builtin_amdgcn_sched_barrier(0);
            SG_MMA(1);
            __builtin_amdgcn_sched_barrier(0);
        }
#undef SG_LOAD
#undef SG_MMA
        LAS float* pw = P + wave * 4096;
#pragma unroll
        for (int i = 0; i < 4; ++i)
#pragma unroll
            for (int j = 0; j < 4; ++j)
#pragma unroll
                for (int r = 0; r < 4; ++r) pw[(16 * i + 4 * g + r) * 64 + 16 * j + il] = acc[i][j][r];
        __syncthreads();
        float sum[8];
#pragma unroll
        for (int e2 = 0; e2 < 8; ++e2) { const int idx = tid + 512 * e2; float v = 0.f;
#pragma unroll
            for (int kp = 0; kp < 8; ++kp) v += P[kp * 4096 + idx];
            sum[e2] = v; }
        if (KQ > 1) {
#pragma unroll
            for (int e2 = 0; e2 < 8; ++e2) { const int idx = tid + 512 * e2, r = idx >> 6, c = idx & 63;
                part[((size_t)kq * 256 + 64 * tm + r) * N + 64 * tn + c] = sum[e2]; }
        } else {
            if (Epi::NEEDS_TILE) { __syncthreads();
#pragma unroll
                for (int e2 = 0; e2 < 8; ++e2) P[tid + 512 * e2] = sum[e2];
                __syncthreads(); }
#pragma unroll
            for (int e2 = 0; e2 < 8; ++e2) { const int idx = tid + 512 * e2, r = idx >> 6, c = idx & 63;
                E(64 * tm + r, 64 * tn + c, sum[e2], P + r * 64, c); }
        }
        __syncthreads();
    }
}
__device__ __forceinline__ float gelu1(float v) { const pg8::f32x2 r = pg8::gelu_pk((pg8::f32x2){v, 0.f}); return r.x; }
struct SEpiEvenIn { static constexpr bool NEEDS_TILE = false; bf16* U; bf16* VG; bf16* PB;
    __device__ __forceinline__ void operator()(int row, int col, float v, const LAS float*, int) const { const size_t m = (size_t)MP + row;
        if (col < 512) U[m * 512 + col] = (bf16)f2bf(gelu1(v)); else if (col < 1024) VG[m * 512 + (col - 512)] = (bf16)f2bf(gelu1(v)); else PB[m * BCOLS + (col - 1024)] = (bf16)f2bf(v); } };
struct SEpiF32 { static constexpr bool NEEDS_TILE = false; bf16* Y; int ldc;
    __device__ __forceinline__ void operator()(int row, int col, float v, const LAS float*, int) const { Y[((size_t)MP + row) * ldc + col] = (bf16)f2bf(v); } };
struct SEpiRelu2 { static constexpr bool NEEDS_TILE = false; bf16* O; int ldc;
    __device__ __forceinline__ void operator()(int row, int col, float v, const LAS float*, int) const { const float a = v > 0.f ? v : 0.f; O[((size_t)MP + row) * ldc + col] = (bf16)f2bf(a * a); } };
struct SEpiQKV { static constexpr bool NEEDS_TILE = true; bf16* Q; float* ks; float* vs; const float* rope;
    __device__ __forceinline__ void operator()(int row, int col, float v, const LAS float* trow, int c) const {
        const int sec = col >> 10, cc = col & 1023, d = cc & 63;
        if (sec < 2 && d < 16) { const float other = trow[c ^ 8]; const float* cs = rope + ((size_t)(2048 + (row & 7)) * 8 + (d & 7)) * 2; v = v * cs[0] + ((d < 8) ? -other : other) * cs[1]; }
        if (sec == 0) Q[((size_t)MP + row) * D + cc] = (bf16)f2bf(v * (0.125f * 1.4426950408889634f));
        else if (sec == 1) ks[(size_t)row * D + cc] = v; else vs[(size_t)row * D + cc] = v; } };

#ifndef REP_GEMM
#define REP_GEMM 1
#endif
#ifndef REP_PREP
#define REP_PREP 1
#endif
#ifndef REP_GMLP
#define REP_GMLP 1
#endif
#ifndef REP_ATTP
#define REP_ATTP 1
#endif
#ifndef REP_ATTS
#define REP_ATTS 1
#endif
#ifndef REP_SCAN
#define REP_SCAN 1
#endif
#ifndef REP_FIN
#define REP_FIN 1
#endif
#ifndef REP_P0
#define REP_P0 1
#endif
#ifndef REP_N0
#define REP_N0 1
#endif
constexpr int N_PHASES = 2 + 10 * DEPTH;
#define RUN(k) (lo <= (k) && (k) < hi)
#define SEAM(k, nk) do { if (RUN(k) && RUN(nk)) xcd_barrier(bar); } while (0)
template <int L> __device__ __forceinline__ void layer_phases(const Args& A, Frame& F, const XcdBarrier& bar, const int lo, const int hi) {

        constexpr int l = L, pb = 2 + 10 * L, eo = L >> 1; constexpr bool even = (L & 1) == 0;
        const pg8::bf16_t* HB = (const pg8::bf16_t*)(A.ws + WS_HB);
        if (RUN(pb)) {
            if constexpr (even) {
                pg8::Gemm g{HB, (const pg8::bf16_t*)(A.ws + WS_WINT) + (size_t)eo * EVEN_IN_PAD * D, MP, EVEN_IN_PAD, D}; pg8::StaticOrder S; S.init(MP, EVEN_IN_PAD, F.G, (int)blockIdx.x);
                pg8::EpiEvenIn E{(pg8::bf16_t*)(A.ws + WS_U), (pg8::bf16_t*)(A.ws + WS_VG), (pg8::bf16_t*)(A.ws + WS_PB)};
                _Pragma("unroll 1") for (int rep_ = 0; rep_ < REP_GEMM; ++rep_) pg8::gemm_phase<pg8::EpiEvenIn, pg8::StaticOrder, PG8_ALIGN, PG8_SP2>(F.lds, g, S, E);
                { SEpiEvenIn SE{(bf16*)(A.ws + WS_U), (bf16*)(A.ws + WS_VG), (bf16*)(A.ws + WS_PB)};
                  const bool light = (F.G == 256); const int rk = light ? (int)blockIdx.x - 192 : F.vcu, nrk = light ? 64 : F.G;
                  if (rk >= 0) small_gemm64(F, (const bf16*)(A.ws + WS_HB) + (size_t)MP * D, (const bf16*)(A.ws + WS_WINT) + (size_t)eo * EVEN_IN_PAD * D, EVEN_IN, D, SE, rk, nrk); }
            } else {
                pg8::Gemm g{HB, (const pg8::bf16_t*)(A.ws + WS_WQKVT) + (size_t)eo * 3 * D * D, MP, 3 * D, D}; pg8::QkvOrder S; S.init(MP, D, F.G, (int)blockIdx.x);
                pg8::EpiQKV E{(pg8::bf16_t*)(A.ws + WS_Q), (pg8::bf16_t*)(A.ws + WS_K), (pg8::bf16_t*)(A.ws + WS_K4), (pg8::bf16_t*)(A.ws + WS_K16), (pg8::bf16_t*)(A.ws + WS_VB),
                              A.out + O_KP + (size_t)eo * MP * D, A.out + O_VP + (size_t)eo * MP * D, A.out + O_KS + (size_t)eo * MS * D, A.out + O_VS + (size_t)eo * MS * D, (const float*)(A.ws + WS_ROPE)};
                _Pragma("unroll 1") for (int rep_ = 0; rep_ < REP_GEMM; ++rep_) pg8::gemm_phase<pg8::EpiQKV, pg8::QkvOrder, PG8_ALIGN, PG8_SP2>(F.lds, g, S, E);
                { SEpiQKV SE{(bf16*)(A.ws + WS_Q), A.out + O_KS + (size_t)eo * MS * D, A.out + O_VS + (size_t)eo * MS * D, (const float*)(A.ws + WS_ROPE)};
                  small_gemm64(F, (const bf16*)(A.ws + WS_HB) + (size_t)MP * D, (const bf16*)(A.ws + WS_WQKVT) + (size_t)eo * 3 * D * D, 3 * D, D, SE, F.vcu, F.G); }
                asm volatile("s_waitcnt vmcnt(0)" ::: "memory"); __syncthreads();
#pragma unroll 1
                for (int i = 0; i < 3; ++i) { pg8::Unit uu; if (!S.next(i, uu)) break; if (uu.pn < 8) continue;
#pragma unroll 1
                    for (int hh = 0; hh < 4; ++hh) vt_build_unit(A, F, (((uu.pm >> 3) * 16 + 4 * (uu.pn - 8) + hh) << 3) | (uu.pm & 7)); }
            }
        }
        if constexpr (even) SEAM(pb, pb + 1); else SEAM(pb, pb + 2);
        if (even && RUN(pb + 1)) {
            if constexpr (even) {
                const bool gfirst = (F.vcu & 4) != 0;
                if (gfirst) { gmlp_prompt_unit(A, F, eo, F.vcu >> 1, F.vcu & 1); rwkv_prep(A, F, eo); }
                else { rwkv_prep(A, F, eo); gmlp_prompt_unit(A, F, eo, F.vcu >> 1, F.vcu & 1); }
                if (F.vcu >= F.G - NSB) gmlp_sample_unit(A, F, eo, F.vcu - (F.G - NSB));
            }
        }
        if constexpr (even) {
            SEAM(pb + 1, pb + 2);
            if (RUN(pb + 2)) {
#ifndef NO_SCAN
 _Pragma("unroll 1") for (int rep_ = 0; rep_ < REP_SCAN; ++rep_) scan_prompt(A, F, eo);
 scan_sample(A, F, eo, F.vcu >> 3, F.vcu & 7);
#endif
 }
            SEAM(pb + 2, pb + 3);
            if (RUN(pb + 3)) {
#ifndef NO_FIN
 _Pragma("unroll 1") for (int rep_ = 0; rep_ < REP_FIN; ++rep_) rwkv_finalize(A, F, eo);
#endif
 }
            SEAM(pb + 3, pb + 4);
        } else {
            if (RUN(pb + 2)) {
                if (F.vcu & 8) {
#pragma unroll 1
                    for (int i = 0; i < 2; ++i) attn_sample_unit(A, F, eo, F.vcu + 256 * i);
#pragma unroll 1
                    for (int i = 0; i < 2; ++i) attn_prompt_unit(A, F, F.vcu + 256 * i);
                } else {
#pragma unroll 1
                    for (int i = 0; i < 2; ++i) attn_prompt_unit(A, F, F.vcu + 256 * i);
#pragma unroll 1
                    for (int i = 0; i < 2; ++i) attn_sample_unit(A, F, eo, F.vcu + 256 * i);
                }
            }
            SEAM(pb + 2, pb + 4);
        }
        if (RUN(pb + 4)) {
            const pg8::bf16_t* W = even ? ((const pg8::bf16_t*)(A.ws + WS_WOUTT) + (size_t)eo * D * D) : ((const pg8::bf16_t*)(A.ws + WS_WOT) + (size_t)eo * D * D);
            pg8::Gemm g{(const pg8::bf16_t*)(A.ws + WS_MIX), W, MP, D, D}; pg8::StaticOrder S; S.init(MP, D, F.G, (int)blockIdx.x);
            pg8::EpiY16 E{(pg8::bf16_t*)(A.ws + WS_Y), D};
            _Pragma("unroll 1") for (int rep_ = 0; rep_ < REP_GEMM; ++rep_) pg8::gemm_phase<pg8::EpiY16, pg8::StaticOrder, PG8_ALIGN, PG8_SP2>(F.lds, g, S, E);
            { SEpiF32 SE{(bf16*)(A.ws + WS_Y), D}; small_gemm<8>(F, (const bf16*)(A.ws + WS_MIX) + (size_t)MP * D, (const bf16*)W, D, D, SE, F.vcu, F.G); }
        }
        SEAM(pb + 4, pb + 5);
        if (RUN(pb + 5)) { norm_phase<1>(A, F, l); } SEAM(pb + 5, pb + 6);
        if (RUN(pb + 6)) {
            pg8::Gemm g{HB, (const pg8::bf16_t*)(A.ws + WS_W1T) + (size_t)l * D * DFF, MP, DFF, D}; pg8::StaticOrder S; S.init(MP, DFF, F.G, (int)blockIdx.x);
            pg8::EpiRelu2 E{(pg8::bf16_t*)(A.ws + WS_FF), DFF};
            _Pragma("unroll 1") for (int rep_ = 0; rep_ < REP_GEMM; ++rep_) pg8::gemm_phase<pg8::EpiRelu2, pg8::StaticOrder, PG8_ALIGN, PG8_SP2>(F.lds, g, S, E);
            { SEpiRelu2 SE{(bf16*)(A.ws + WS_FF), DFF}; small_gemm64(F, (const bf16*)(A.ws + WS_HB) + (size_t)MP * D, (const bf16*)(A.ws + WS_W1T) + (size_t)l * D * DFF, DFF, D, SE, F.vcu, F.G); }
        }
        SEAM(pb + 6, pb + 7);
        if (RUN(pb + 7)) {
            pg8::Gemm g{(const pg8::bf16_t*)(A.ws + WS_FF), (const pg8::bf16_t*)(A.ws + WS_W2T) + (size_t)l * D * DFF, MP, D, DFF}; pg8::StaticOrder S; S.init(MP, D, F.G, (int)blockIdx.x);
            pg8::EpiY16 E{(pg8::bf16_t*)(A.ws + WS_Y), D};
            _Pragma("unroll 1") for (int rep_ = 0; rep_ < REP_GEMM; ++rep_) pg8::gemm_phase<pg8::EpiY16, pg8::StaticOrder, PG8_ALIGN, PG8_SP2>(F.lds, g, S, E);
            { SEpiF32 SE{(bf16*)(A.ws + WS_Y), D}; small_gemm64<SEpiF32, 4>(F, (const bf16*)(A.ws + WS_FF) + (size_t)MP * DFF, (const bf16*)(A.ws + WS_W2T) + (size_t)l * D * DFF, D, DFF, SE, F.vcu, F.G, (float*)(A.ws + WS_OSC)); }
        }
        SEAM(pb + 7, pb + 8);
        if (RUN(pb + 8)) { norm_phase<2>(A, F, l); }
        if (l + 1 < DEPTH) SEAM(pb + 8, pb + 10);

}
#undef RUN
#undef SEAM

__global__ void __launch_bounds__(NWAVES * 64, 2) fwd_kernel(Args A) {
    extern __shared__ __attribute__((aligned(16))) unsigned char lds_raw[];
    Frame F;
    F.lds = (LAS unsigned char*)lds_raw;
    F.MISC = (volatile LAS unsigned*)(F.lds + MISC_OFF);
    F.tid = threadIdx.x; F.lane = F.tid & 63; F.wave = __builtin_amdgcn_readfirstlane(F.tid >> 6);
    F.G = gridDim.x; { const int bx = blockIdx.x; F.vcu = (F.G % 8 == 0) ? (bx % 8) * (F.G / 8) + bx / 8 : bx; }
    F.ctl = (gu32*)(A.ws + WS_CTL);
    for (int u = F.tid; u < (LDS_BYTES - LDSCTL_OFF) / 4; u += NWAVES * 64) ((LAS unsigned*)(F.lds + LDSCTL_OFF))[u] = 0u;
    __syncthreads();
    const int lo = A.ph_lo, hi = A.ph_hi;
    XcdBarrier bar; bar.bar = (unsigned*)(F.ctl + CW_BAR); bar.x = 0; bar.st = nullptr;
    if (hi - lo > 1) bar = xcd_barrier_post((unsigned*)(F.ctl + CW_BAR), F.MISC + 8);
#define RUN(k) (lo <= (k) && (k) < hi)
#define SEAM(k, nk) do { if (RUN(k) && RUN(nk)) xcd_barrier(bar); } while (0)

    if (RUN(0)) {
#ifndef NO_P0
 _Pragma("unroll 1") for (int rep_ = 0; rep_ < REP_P0; ++rep_) { p0_prologue(A, F); __syncthreads(); }
#endif
 } SEAM(0, 1);
    if (RUN(1)) {
#ifndef NO_N
 _Pragma("unroll 1") for (int rep_ = 0; rep_ < REP_N0; ++rep_) norm_phase<0>(A, F, 0);
#endif
 } SEAM(1, 2);

    layer_phases<0>(A, F, bar, lo, hi); layer_phases<1>(A, F, bar, lo, hi); layer_phases<2>(A, F, bar, lo, hi); layer_phases<3>(A, F, bar, lo, hi);
#undef RUN
#undef SEAM
}

extern "C" void kernel_launch(void* const* d_in, const int* in_sizes, int n_in, void* d_out, int out_size, void* d_ws, size_t ws_size, hipStream_t stream) {
    static int grid = 0;
    if (grid == 0) {
        if (n_in != N_IN || (size_t)out_size != O_END || ws_size < WS_END) { fprintf(stderr, "kernel_launch: expected %d inputs, %zu outputs, >= %zu bytes of workspace; got %d, %d, %zu; nothing launched\n", (int)N_IN, (size_t)O_END, (size_t)WS_END, n_in, out_size, ws_size); grid = -1; return; }
        int dev = 0, cus = 0, per_cu = 0;
        if (hipGetDevice(&dev) != hipSuccess || hipDeviceGetAttribute(&cus, hipDeviceAttributeMultiprocessorCount, dev) != hipSuccess) { fprintf(stderr, "kernel_launch: device query failed\n"); grid = -1; return; }
        if (hipFuncSetAttribute((const void*)fwd_kernel, hipFuncAttributeMaxDynamicSharedMemorySize, LDS_BYTES) != hipSuccess) { fprintf(stderr, "kernel_launch: hipFuncSetAttribute failed\n"); grid = -1; return; }
        if (hipOccupancyMaxActiveBlocksPerMultiprocessor(&per_cu, (const void*)fwd_kernel, NWAVES * 64, LDS_BYTES) != hipSuccess || per_cu < 1)
            fprintf(stderr, "kernel_launch: note: occupancy query reports %d workgroups per CU\n", per_cu);
        (void)hipGetLastError();
        grid = cus;
        if (grid != 256) fprintf(stderr, "kernel_launch: %d CUs; this kernel is laid out for 256\n", grid);
    }
    if (grid < 0) return;
    if (hipMemsetAsync((char*)d_ws + WS_CTL, 0, CTL_ZERO_BYTES, stream) != hipSuccess) { fprintf(stderr, "kernel_launch: memset failed\n"); return; }
    Args a{};
    for (int i = 0; i < N_IN; ++i) a.in[i] = (const float*)d_in[i];
    a.out = (float*)d_out; a.ws = (unsigned char*)d_ws;
#if MK_PER_PHASE
    for (int k = 0; k < N_PHASES; ++k) {
        int cls = k;
        if (k >= 2) { const int l = (k - 2) / 10, j = (k - 2) % 10; if (j == 9) continue; if ((l & 1) && (j == 1 || j == 3)) continue;
            cls = (j == 0) ? ((l & 1) ? 3 : 2) : (j == 1) ? ((l & 1) ? 11 : 4) : (j == 2) ? ((l & 1) ? 5 : 6) : (j == 3) ? 7 : (j == 4) ? 8 : (j == 6) ? 9 : (j == 7) ? 10 : 31; }
        a.ph_lo = k; a.ph_hi = k + 1;
        const int nrep = ((PROBE_DUP_MASK >> cls) & 1) ? 2 : 1;
        for (int r = 0; r < nrep; ++r) hipLaunchKernelGGL(fwd_kernel, dim3(grid), dim3(NWAVES * 64), LDS_BYTES, stream, a);
    }
#else
    a.ph_lo = 0; a.ph_hi = N_PHASES;
    hipLaunchKernelGGL(fwd_kernel, dim3(grid), dim3(NWAVES * 64), LDS_BYTES, stream, a);
#endif
    const hipError_t le = hipPeekAtLastError();
    if (le != hipSuccess) fprintf(stderr, "kernel_launch: launch failed: %s\n", hipGetErrorName(le));
}
```
